# Optimizing an MI355X kernel written in HIP

```python
import jax
import jax.numpy as jnp
from jax import lax

D_MODEL = 1024
BATCH = 8
SEQ = 2048
DEPTH = 4

N_ATTN_HEADS = 8
HEAD_DIM = 64
ATTN_WIDTH = N_ATTN_HEADS * HEAD_DIM
MOBA_BLOCK = 256
MOBA_TOPK = 3
MOBA_Q_BLOCK = 64
N_SGU_GROUPS = 8
SGU_GROUP_DIM = 64
SGU_WIDTH = N_SGU_GROUPS * SGU_GROUP_DIM
SGU_CHUNK = 128
D_FF = 2816
CONV_WIDTH = 3
N_MOD = 6
EPS = 1e-6
IN_WIDTH = 3 * ATTN_WIDTH + 2 * SGU_WIDTH + 2 * D_MODEL

kernel_name = 'hybrid_moba_gmlp_convffn_adaln'


def rms_norm(x, g):
    xf = x.astype(jnp.float32)
    y = xf * lax.rsqrt(jnp.mean(xf * xf, axis=-1, keepdims=True) + EPS)
    return (y * g.astype(jnp.float32)).astype(x.dtype)


def modulate(h, shift, scale):
    return h * (1 + scale[:, None, :]) + shift[:, None, :]


def moba_attention(q, k, v):
    b, s, h, dh = q.shape
    s_pad = -(-s // MOBA_BLOCK) * MOBA_BLOCK
    pad = ((0, 0), (0, s_pad - s), (0, 0), (0, 0))
    nb = s_pad // MOBA_BLOCK
    q = jnp.pad(q * dh ** -0.5, pad).transpose(0, 2, 1, 3)
    kb = jnp.pad(k, pad).transpose(0, 2, 1, 3).reshape(b, h, nb, MOBA_BLOCK, dh)
    vb = jnp.pad(v, pad).transpose(0, 2, 1, 3).reshape(b, h, nb, MOBA_BLOCK, dh)
    topk = min(MOBA_TOPK, nb)
    k_mean = jnp.mean(kb.astype(jnp.float32), axis=3)
    route = jnp.einsum('bhsd,bhnd->bhsn', q.astype(jnp.float32), k_mean)
    q_block = jnp.arange(s_pad) // MOBA_BLOCK
    fully_past = jnp.arange(nb)[None, :] < q_block[:, None]
    route = jnp.where(fully_past, route, -jnp.inf)
    _, sel = lax.top_k(route, topk)
    nq = s_pad // MOBA_Q_BLOCK
    q_c = q.reshape(b, h, nq, MOBA_Q_BLOCK, dh).transpose(2, 0, 1, 3, 4)
    sel_c = sel.reshape(b, h, nq, MOBA_Q_BLOCK, topk).transpose(2, 0, 1, 3, 4)
    bi = jnp.arange(b)[:, None, None, None]
    hi = jnp.arange(h)[None, :, None, None]

    def query_block(args):
        ci, qc, selc = args
        pos_q = ci * MOBA_Q_BLOCK + jnp.arange(MOBA_Q_BLOCK)
        blk = (ci * MOBA_Q_BLOCK) // MOBA_BLOCK
        k_sel = kb[bi, hi, selc]
        v_sel = vb[bi, hi, selc]
        s_sel = jnp.einsum('bhqd,bhqnkd->bhqnk', qc, k_sel).astype(jnp.float32)
        valid = jnp.arange(topk)[None, :] < (pos_q // MOBA_BLOCK)[:, None]
        s_sel = jnp.where(valid[None, None, :, :, None], s_sel, -jnp.inf)
        k_own = lax.dynamic_index_in_dim(kb, blk, axis=2, keepdims=False)
        v_own = lax.dynamic_index_in_dim(vb, blk, axis=2, keepdims=False)
        s_own = jnp.einsum('bhqd,bhkd->bhqk', qc, k_own).astype(jnp.float32)
        pos_k = blk * MOBA_BLOCK + jnp.arange(MOBA_BLOCK)
        s_own = jnp.where(pos_k[None, :] <= pos_q[:, None], s_own, -jnp.inf)
        scores = jnp.concatenate(
            [s_sel.reshape(b, h, MOBA_Q_BLOCK, topk * MOBA_BLOCK), s_own], axis=-1)
        p = jax.nn.softmax(scores, axis=-1).astype(v.dtype)
        p_sel = p[..., :topk * MOBA_BLOCK].reshape(b, h, MOBA_Q_BLOCK, topk, MOBA_BLOCK)
        p_own = p[..., topk * MOBA_BLOCK:]
        return (jnp.einsum('bhqnk,bhqnkd->bhqd', p_sel, v_sel)
                + jnp.einsum('bhqk,bhkd->bhqd', p_own, v_own))

    out = lax.map(query_block, (jnp.arange(nq), q_c, sel_c))
    out = out.transpose(1, 0, 3, 2, 4).reshape(b, s_pad, h * dh)
    return out[:, :s]


def spatial_gating(u, v, g_v, w_s, b_s):
    b, s, _ = v.shape
    v = rms_norm(v, g_v).reshape(b, s // SGU_CHUNK, SGU_CHUNK, N_SGU_GROUPS, SGU_GROUP_DIM)
    causal = jnp.tril(jnp.ones((SGU_CHUNK, SGU_CHUNK), dtype=bool))
    w = jnp.where(causal[None], w_s, 0)
    mixed = jnp.einsum('gij,bnjgc->bnigc', w, v) + b_s.T[None, None, :, :, None]
    return u * mixed.reshape(b, s, SGU_WIDTH)


def causal_dwconv(h, w, bias):
    s = h.shape[1]
    hp = jnp.pad(h, ((0, 0), (CONV_WIDTH - 1, 0), (0, 0)))
    out = bias + w[CONV_WIDTH - 1] * h
    for i in range(CONV_WIDTH - 1):
        out = out + w[i] * hp[:, i:i + s]
    return out


def setup_inputs(seed: int = 0) -> dict:
    key = jax.random.key(seed)
    ks = jax.random.split(key, 18)

    def nrm(k, shape, scale):
        return jax.random.normal(k, shape, jnp.float32) * scale

    L = DEPTH
    return {
        'x': nrm(ks[0], (BATCH, SEQ, D_MODEL), 1.0),
        'c': nrm(ks[1], (BATCH, D_MODEL), 1.0),
        'w_mod': nrm(ks[2], (L, D_MODEL, N_MOD * D_MODEL), 0.5 * D_MODEL ** -0.5),
        'b_mod': nrm(ks[3], (L, N_MOD * D_MODEL), 0.02),
        'g_mix': 1.0 + nrm(ks[4], (L, D_MODEL), 0.05),
        'w_in': nrm(ks[5], (L, D_MODEL, IN_WIDTH), D_MODEL ** -0.5),
        'g_sgu': 1.0 + nrm(ks[6], (L, SGU_WIDTH), 0.05),
        'w_sgu_s': nrm(ks[7], (L, N_SGU_GROUPS, SGU_CHUNK, SGU_CHUNK), SGU_CHUNK ** -0.5),
        'b_sgu_s': 1.0 + nrm(ks[8], (L, N_SGU_GROUPS, SGU_CHUNK), 0.1),
        'w_attn_br': nrm(ks[9], (L, ATTN_WIDTH, D_MODEL), ATTN_WIDTH ** -0.5),
        'w_sgu_br': nrm(ks[10], (L, SGU_WIDTH, D_MODEL), SGU_WIDTH ** -0.5),
        'w_out': nrm(ks[11], (L, D_MODEL, D_MODEL), D_MODEL ** -0.5),
        'g_ffn': 1.0 + nrm(ks[12], (L, D_MODEL), 0.05),
        'w_up': nrm(ks[13], (L, D_MODEL, 2 * D_FF), D_MODEL ** -0.5),
        'w_conv': nrm(ks[14], (L, CONV_WIDTH, 2 * D_FF), CONV_WIDTH ** -0.5),
        'b_conv': nrm(ks[15], (L, 2 * D_FF), 0.02),
        'w_down': nrm(ks[16], (L, D_FF, D_MODEL), D_FF ** -0.5),
        'g_final': 1.0 + nrm(ks[17], (D_MODEL,), 0.05),
    }


def reference(x, c, w_mod, b_mod, g_mix, w_in, g_sgu, w_sgu_s, b_sgu_s, w_attn_br,
              w_sgu_br, w_out, g_ffn, w_up, w_conv, b_conv, w_down, g_final):
    b, s, _ = x.shape
    a3 = 3 * ATTN_WIDTH
    splits = [ATTN_WIDTH, 2 * ATTN_WIDTH, a3, a3 + SGU_WIDTH, a3 + 2 * SGU_WIDTH,
              a3 + 2 * SGU_WIDTH + D_MODEL]
    c_act = jax.nn.silu(c)
    for l in range(DEPTH):
        mod = c_act @ w_mod[l] + b_mod[l]
        shift_m, scale_m, gate_m, shift_f, scale_f, gate_f = jnp.split(mod, N_MOD, axis=-1)

        h = modulate(rms_norm(x, g_mix[l]), shift_m, scale_m)
        q, k, v, u, vs, gate_a, gate_s = jnp.split(h @ w_in[l], splits, axis=-1)
        head_shape = (b, s, N_ATTN_HEADS, HEAD_DIM)
        y_attn = moba_attention(q.reshape(head_shape), k.reshape(head_shape),
                                v.reshape(head_shape)) @ w_attn_br[l]
        y_sgu = spatial_gating(jax.nn.gelu(u), jax.nn.gelu(vs), g_sgu[l],
                               w_sgu_s[l], b_sgu_s[l]) @ w_sgu_br[l]
        merged = jax.nn.sigmoid(gate_a) * y_attn + jax.nn.sigmoid(gate_s) * y_sgu
        x = x + gate_m[:, None, :] * (merged @ w_out[l])

        h = modulate(rms_norm(x, g_ffn[l]), shift_f, scale_f)
        act, lin = jnp.split(causal_dwconv(h @ w_up[l], w_conv[l], b_conv[l]), 2, axis=-1)
        x = x + gate_f[:, None, :] * ((jax.nn.silu(act) * lin) @ w_down[l])
    return rms_norm(x, g_final)
```

```cpp
#include <hip/hip_runtime.h>
#include <hip/hip_cooperative_groups.h>
#include <hip/hip_bf16.h>
#include <cstdio>
#include <cstdint>
#include <cmath>
namespace cg = cooperative_groups;
namespace pg8 {
#define PG8_LAS __attribute__((address_space(3)))
typedef unsigned short bf16_t;
typedef short bf16x8 __attribute__((ext_vector_type(8)));
typedef float f32x4 __attribute__((ext_vector_type(4)));
typedef unsigned u32x4 __attribute__((ext_vector_type(4)));
constexpr int BM = 256, BK = 64, HALF = 128, HTB = HALF * BK * 2  , STAGE_BYTES = 8 * HTB, NXCD = 8, WGM = 8;

__host__ __device__ __forceinline__ int lds_byte(int r, int c) { const int st = (r >> 4) * 2 + (c >> 5), rr = r & 15, cc = c & 31, ob = rr * 64 + cc * 2; return st * 1024 + (ob ^ (((ob >> 9) & 1) << 5)); }
__host__ __device__ __forceinline__ void stage_rc(int b, int& R, int& C) { const int st = b / 1024, sb = b % 1024, swz = sb ^ (((sb >> 9) & 1) << 5); R = (st >> 1) * 16 + swz / 64; C = (st & 1) * 32 + (swz % 64) / 2; }
__host__ __device__ __forceinline__ int perm32(int rho) { const int n = rho >> 4, i = rho & 15; return 8 * (i >> 2) + 4 * n + (i & 3); }

struct Unit { int pm, pn; };
struct Gemm { const bf16_t* A; const bf16_t* Bt; int M, N, K, lda; };

struct StaticOrder {
    int nM, nN, nwg, G, c;
    __host__ __device__ void init(int M, int N, int G_, int c_) { nM = M / BM; nN = N / BM; nwg = nM * nN; G = G_; c = c_; }
    __host__ __device__ bool next(int i, Unit& u) const {
        const long L = (long)i * G + c; if (L >= nwg) return false;
        int wgid = (int)L; { const int q = nwg / NXCD, r = nwg % NXCD, xcd = wgid % NXCD, off = wgid / NXCD; wgid = (xcd < r ? xcd * (q + 1) : r * (q + 1) + (xcd - r) * q) + off; }
        const int nig = WGM * nN, gid = wgid / nig, fm = gid * WGM, gsz = (nM - fm) < WGM ? (nM - fm) : WGM;
        u.pm = fm + ((wgid % nig) % gsz); u.pn = (wgid % nig) / gsz; return true;
    }
    __device__ __forceinline__ void a_ready(const Unit&) const {}
    __device__ __forceinline__ void done(const Unit&) const {}
};

__device__ __forceinline__ unsigned cvt_pk_bf16(float lo, float hi) { unsigned r; asm volatile("v_cvt_pk_bf16_f32 %0, %1, %2" : "=v"(r) : "v"(lo), "v"(hi)); return r; }
typedef float f32x2 __attribute__((ext_vector_type(2)));
__device__ __forceinline__ float fast_sigmoid(float x) { return __builtin_amdgcn_rcpf(1.0f + __builtin_amdgcn_exp2f(-1.4426950408889634f * x)); }
__device__ __forceinline__ float gelu_tanh(float x) { const float z2 = 1.5957691216057308f * (x + 0.044715f * x * x * x); return x * fast_sigmoid(z2); }
__device__ __forceinline__ float bf_lo(unsigned w) { return __uint_as_float(w << 16); }
__device__ __forceinline__ float bf_hi(unsigned w) { return __uint_as_float(w & 0xffff0000u); }
constexpr float QSCALE = 0.125f * 1.4426950408889634f;

struct EpiIn {
    static constexpr bool PERM = true, AFTER_DRAIN = false;
    bf16_t* P; float* kms;
    __device__ __forceinline__ void operator()(const f32x4 (&acc)[2][2][4][2], const Unit& u, int wr, int wc, int fr, int fq) const {
        const int pn = u.pn;
        const int row0 = u.pm * BM + wr * 64 + fr, col0 = pn * BM + wc * 32 + 8 * fq;
        f32x4 ks[2][2];
#pragma unroll
        for (int a = 0; a < 2; ++a)
#pragma unroll
            for (int b = 0; b < 2; ++b) ks[a][b] = (f32x4){0.f, 0.f, 0.f, 0.f};
#pragma unroll
        for (int ai = 0; ai < 2; ++ai)
#pragma unroll
            for (int m = 0; m < 4; ++m) { bf16_t* rowp = P + (size_t)(row0 + ai * HALF + m * 16) * 4608 + col0;
#pragma unroll
                for (int bj = 0; bj < 2; ++bj) { f32x4 v0 = acc[ai][bj][m][0], v1 = acc[ai][bj][m][1];
                    if (pn < 2) { v0 = v0 * QSCALE; v1 = v1 * QSCALE; }
                    else if (pn < 4) { ks[bj][0] += v0; ks[bj][1] += v1; }
                    else if (pn < 6) { }
                    else if (pn < 10) {
#pragma unroll
                        for (int i = 0; i < 4; ++i) { v0[i] = gelu_tanh(v0[i]); v1[i] = gelu_tanh(v1[i]); } }
                    else {
#pragma unroll
                        for (int i = 0; i < 4; ++i) { v0[i] = fast_sigmoid(v0[i]); v1[i] = fast_sigmoid(v1[i]); } }
                    u32x4 w; w.x = cvt_pk_bf16(v0[0], v0[1]); w.y = cvt_pk_bf16(v0[2], v0[3]); w.z = cvt_pk_bf16(v1[0], v1[1]); w.w = cvt_pk_bf16(v1[2], v1[3]);
                    *(u32x4*)(rowp + bj * HALF) = w; } }
        if (pn >= 2 && pn < 4) {
            const int b = u.pm >> 3, blk = u.pm & 7;
#pragma unroll
            for (int bj = 0; bj < 2; ++bj)
#pragma unroll
                for (int n = 0; n < 2; ++n)
#pragma unroll
                    for (int i = 0; i < 4; ++i) { float s = ks[bj][n][i];
                        s += __shfl_xor(s, 1); s += __shfl_xor(s, 2); s += __shfl_xor(s, 4); s += __shfl_xor(s, 8);
                        if (fr == 0) { const int kc = (pn - 2) * 256 + bj * 128 + wc * 32 + 8 * fq + 4 * n + i; const int h = kc >> 6, d = kc & 63;
                            kms[(size_t)wr * 32768 + ((size_t)((b * 8 + h) * 8 + blk)) * 64 + d] = s; } }
        }
    }
};

struct EpiBranch {
    static constexpr bool PERM = true, AFTER_DRAIN = false;
    const bf16_t* Gt; bf16_t* Mg; int accum;
    __device__ __forceinline__ void operator()(const f32x4 (&acc)[2][2][4][2], const Unit& u, int wr, int wc, int fr, int fq) const {
        const int row0 = u.pm * BM + wr * 64 + fr, col0 = u.pn * BM + wc * 32 + 8 * fq;
#pragma unroll
        for (int ai = 0; ai < 2; ++ai)
#pragma unroll
            for (int m = 0; m < 4; ++m) { const size_t row = (size_t)(row0 + ai * HALF + m * 16);
#pragma unroll
                for (int bj = 0; bj < 2; ++bj) { const int col = col0 + bj * HALF;
                    const u32x4 g = *(const u32x4*)(Gt + row * 4608 + col);
                    const f32x4 a0 = acc[ai][bj][m][0], a1 = acc[ai][bj][m][1];
                    float o0 = bf_lo(g.x) * a0[0], o1 = bf_hi(g.x) * a0[1], o2 = bf_lo(g.y) * a0[2], o3 = bf_hi(g.y) * a0[3];
                    float o4 = bf_lo(g.z) * a1[0], o5 = bf_hi(g.z) * a1[1], o6 = bf_lo(g.w) * a1[2], o7 = bf_hi(g.w) * a1[3];
                    bf16_t* mp = Mg + row * 1024 + col;
                    if (accum) { const u32x4 p = *(const u32x4*)mp;
                        o0 += bf_lo(p.x); o1 += bf_hi(p.x); o2 += bf_lo(p.y); o3 += bf_hi(p.y); o4 += bf_lo(p.z); o5 += bf_hi(p.z); o6 += bf_lo(p.w); o7 += bf_hi(p.w); }
                    u32x4 w; w.x = cvt_pk_bf16(o0, o1); w.y = cvt_pk_bf16(o2, o3); w.z = cvt_pk_bf16(o4, o5); w.w = cvt_pk_bf16(o6, o7);
                    *(u32x4*)mp = w; } }
    }
};

struct EpiRes {
    static constexpr bool PERM = false, AFTER_DRAIN = false;
    const float* base; float* out; const float* gate;
    __device__ __forceinline__ void operator()(const f32x4 (&acc)[2][2][4][2], const Unit& u, int wr, int wc, int fr, int fq) const {
        const float* gp = gate + (size_t)(u.pm >> 3) * 6144;
        const int col0 = u.pn * BM + wc * 32 + 4 * fq;
#pragma unroll
        for (int bj = 0; bj < 2; ++bj)
#pragma unroll
            for (int n = 0; n < 2; ++n) { const int c = col0 + bj * HALF + n * 16; const f32x4 g4 = *(const f32x4*)(gp + c);
#pragma unroll
                for (int ai = 0; ai < 2; ++ai)
#pragma unroll
                    for (int m = 0; m < 4; ++m) { const size_t off = (size_t)(u.pm * BM + ai * HALF + wr * 64 + m * 16 + fr) * 1024 + c;
                        const f32x4 bs = *(const f32x4*)(base + off); *(f32x4*)(out + off) = bs + g4 * acc[ai][bj][m][n]; } }
    }
};

struct EpiPlain {
    static constexpr bool PERM = true, AFTER_DRAIN = false;
    bf16_t* O; int ldc;
    __device__ __forceinline__ void operator()(const f32x4 (&acc)[2][2][4][2], const Unit& u, int wr, int wc, int fr, int fq) const {
        const int row0 = u.pm * BM + wr * 64 + fr, col0 = u.pn * BM + wc * 32 + 8 * fq;
#pragma unroll
        for (int ai = 0; ai < 2; ++ai)
#pragma unroll
            for (int m = 0; m < 4; ++m) { bf16_t* rowp = O + (size_t)(row0 + ai * HALF + m * 16) * ldc + col0;
#pragma unroll
                for (int bj = 0; bj < 2; ++bj) { const f32x4 v0 = acc[ai][bj][m][0], v1 = acc[ai][bj][m][1];
                    u32x4 w; w.x = cvt_pk_bf16(v0[0], v0[1]); w.y = cvt_pk_bf16(v0[2], v0[3]); w.z = cvt_pk_bf16(v1[0], v1[1]); w.w = cvt_pk_bf16(v1[2], v1[3]);
                    *(u32x4*)(rowp + bj * HALF) = w; } }
    }
};
template <class Epi, class Sched, bool ALIGN_EPI = false, bool SP2 = false>
__device__ __forceinline__ void gemm_phase(PG8_LAS unsigned char* lds, const Gemm g, const Sched& S, const Epi& E) {
    int tid_l = threadIdx.x; asm volatile("" : "+v"(tid_l)); const int tid = tid_l, wid = __builtin_amdgcn_readfirstlane(tid >> 6), lane = tid & 63, wr = wid >> 2, wc = wid & 3, fr = lane & 15, fq = lane >> 4;
    const int K = g.K, nt = K / BK, lda = g.lda;
    unsigned voffA[2], voffB[2];
#pragma unroll
    for (int i = 0; i < 2; ++i) { int R, C; stage_rc(tid * 16 + i * 8192, R, C); const int Rb = Epi::PERM ? ((R & ~31) + perm32(R & 31)) : R;
        voffA[i] = (unsigned)(R * lda + C) * 2u; voffB[i] = (unsigned)(Rb * K + C) * 2u; }
    const size_t kstep = (size_t)(BK * 2);
    const size_t hstep = (size_t)HALF * K * 2;
    const size_t tstep = 2 * hstep; const size_t hstepA = (size_t)HALF * lda * 2, tstepA = 2 * hstepA;
    const unsigned ldsw = (unsigned)wid * 1024u;
    const int aoff = lds_byte(wr * 64 + fr, fq * 8), boff = lds_byte(wc * 32 + fr, fq * 8);
#define PG8_SA(b, h) (((b) * 2 + (h)) * HTB)
#define PG8_SB(b, h) ((4 + (b) * 2 + (h)) * HTB)
#define PG8_STAGE(bufoff, gbase, voff) do { _Pragma("unroll") for (int _i = 0; _i < 2; ++_i) \
        __builtin_amdgcn_global_load_lds((const unsigned*)((const char*)(gbase) + (voff)[_i]), (PG8_LAS unsigned*)(lds + (bufoff) + ldsw + _i * 8192), 16, 0, 0); } while (0)
#define PG8_LDA(dst, b, h) do { _Pragma("unroll") for (int m = 0; m < 4; ++m) _Pragma("unroll") for (int k = 0; k < 2; ++k) dst[m][k] = *(const PG8_LAS bf16x8*)(lds + PG8_SA(b, h) + aoff + m * 2048 + k * 1024); } while (0)
#define PG8_LDB(dst, b, h) do { _Pragma("unroll") for (int n = 0; n < 2; ++n) _Pragma("unroll") for (int k = 0; k < 2; ++k) dst[n][k] = *(const PG8_LAS bf16x8*)(lds + PG8_SB(b, h) + boff + n * 2048 + k * 1024); } while (0)
#define PG8_MMA(ai, bj, At, Bt) do { __builtin_amdgcn_s_setprio(1); _Pragma("unroll") for (int m = 0; m < 4; ++m) _Pragma("unroll") for (int n = 0; n < 2; ++n) _Pragma("unroll") for (int k = 0; k < 2; ++k) \
        acc[ai][bj][m][n] = __builtin_amdgcn_mfma_f32_16x16x32_bf16(Bt[n][k], At[m][k], acc[ai][bj][m][n], 0, 0, 0); __builtin_amdgcn_s_setprio(0); } while (0)
#define PG8_WAIT_V(n) asm volatile("s_waitcnt vmcnt(" #n ")" ::: "memory")
#define PG8_WAIT_L(n) asm volatile("s_waitcnt lgkmcnt(" #n ")" ::: "memory")
#define PG8_BAR __builtin_amdgcn_s_barrier()
#define PG8_SCHED __builtin_amdgcn_sched_barrier(0)
    Unit cur, nxt; int ui = 0;
    if (!S.next(0, cur)) return;
    f32x4 acc[2][2][4][2];
#pragma unroll
    for (int a = 0; a < 2; ++a)
#pragma unroll
        for (int b = 0; b < 2; ++b)
#pragma unroll
            for (int m = 0; m < 4; ++m)
#pragma unroll
                for (int n = 0; n < 2; ++n) acc[a][b][m][n] = (f32x4){0.f, 0.f, 0.f, 0.f};
    bf16x8 At[4][2], B0[2][2], B1[2][2];
    const char* cA = (const char*)g.A + (size_t)cur.pm * tstepA; const char* cB = (const char*)g.Bt + (size_t)cur.pn * tstep;
    S.a_ready(cur);
    if constexpr (SP2) {
        PG8_STAGE(PG8_SB(0, 0), cB, voffB); PG8_STAGE(PG8_SB(0, 1), cB + hstep, voffB); PG8_STAGE(PG8_SA(0, 0), cA, voffA); PG8_STAGE(PG8_SA(0, 1), cA + hstepA, voffA);
        if (wr == 1) PG8_BAR;
        PG8_WAIT_V(2); PG8_BAR;
        PG8_STAGE(PG8_SB(1, 0), cB + kstep, voffB); PG8_STAGE(PG8_SA(1, 0), cA + kstep, voffA); PG8_STAGE(PG8_SB(1, 1), cB + hstep + kstep, voffB);
        PG8_WAIT_V(6); PG8_BAR;
    } else {
        PG8_STAGE(PG8_SB(0, 0), cB, voffB); PG8_STAGE(PG8_SA(0, 0), cA, voffA); PG8_STAGE(PG8_SB(0, 1), cB + hstep, voffB); PG8_STAGE(PG8_SA(0, 1), cA + hstepA, voffA);
        if (wr == 1) PG8_BAR;
        PG8_WAIT_V(4); PG8_BAR;
        PG8_STAGE(PG8_SB(1, 0), cB + kstep, voffB); PG8_STAGE(PG8_SA(1, 0), cA + kstep, voffA); PG8_STAGE(PG8_SB(1, 1), cB + hstep + kstep, voffB);
        PG8_WAIT_V(6); PG8_BAR;
    }
    for (;;) {
        const bool has_next = S.next(ui + 1, nxt);
        const char* nA = has_next ? (const char*)g.A + (size_t)nxt.pm * tstepA : cA; const char* nB = has_next ? (const char*)g.Bt + (size_t)nxt.pn * tstep : cB;
        for (int t = 0; t < nt; t += 2) {
            const bool last = (t == nt - 2);
            const char* a1 = cA + (size_t)(t + 1) * kstep;
            const char* a2 = last ? nA : cA + (size_t)(t + 2) * kstep; const char* b2 = last ? nB : cB + (size_t)(t + 2) * kstep;
            const char* a3 = a2 + kstep; const char* b3 = b2 + kstep;
            if (last && has_next) S.a_ready(nxt);
            if constexpr (SP2) {
            PG8_LDB(B0, 0, 0); PG8_LDB(B1, 0, 1); PG8_SCHED; PG8_LDA(At, 0, 0); PG8_STAGE(PG8_SA(1, 1), a1 + hstepA, voffA);
            PG8_WAIT_V(8); PG8_WAIT_L(0); PG8_BAR; PG8_MMA(0, 0, At, B0); PG8_MMA(0, 1, At, B1); PG8_BAR; PG8_SCHED;
            PG8_LDA(At, 0, 1); PG8_STAGE(PG8_SB(0, 0), b2, voffB); PG8_STAGE(PG8_SB(0, 1), b2 + hstep, voffB); PG8_STAGE(PG8_SA(0, 0), a2, voffA);
            PG8_WAIT_V(8); PG8_WAIT_L(0); PG8_BAR; PG8_MMA(1, 0, At, B0); PG8_MMA(1, 1, At, B1); PG8_BAR; PG8_SCHED;
            PG8_LDB(B0, 1, 0); PG8_LDB(B1, 1, 1); PG8_SCHED; PG8_LDA(At, 1, 0); PG8_STAGE(PG8_SA(0, 1), a2 + hstepA, voffA);
            PG8_WAIT_V(8); PG8_WAIT_L(0); PG8_BAR; PG8_MMA(0, 0, At, B0); PG8_MMA(0, 1, At, B1); PG8_BAR; PG8_SCHED;
            PG8_LDA(At, 1, 1); PG8_STAGE(PG8_SB(1, 0), b3, voffB); PG8_STAGE(PG8_SB(1, 1), b3 + hstep, voffB); PG8_STAGE(PG8_SA(1, 0), a3, voffA);
            PG8_WAIT_V(8); PG8_WAIT_L(0); PG8_BAR; PG8_MMA(1, 0, At, B0); PG8_MMA(1, 1, At, B1); PG8_BAR; PG8_SCHED;
            } else {
            PG8_LDB(B0, 0, 0); PG8_SCHED; PG8_LDA(At, 0, 0); PG8_STAGE(PG8_SA(1, 1), a1 + hstepA, voffA);
            PG8_WAIT_L(8); PG8_BAR; PG8_WAIT_L(0); PG8_MMA(0, 0, At, B0); PG8_BAR; PG8_SCHED;
            PG8_LDB(B1, 0, 1); PG8_STAGE(PG8_SB(0, 0), b2, voffB);
            PG8_BAR; PG8_WAIT_L(0); PG8_MMA(0, 1, At, B1); PG8_BAR;
            PG8_LDA(At, 0, 1); PG8_STAGE(PG8_SA(0, 0), a2, voffA);
            PG8_BAR; PG8_WAIT_L(0); PG8_MMA(1, 0, At, B0); PG8_BAR; PG8_SCHED;
            PG8_STAGE(PG8_SB(0, 1), b2 + hstep, voffB);
            PG8_WAIT_V(6); PG8_BAR; PG8_MMA(1, 1, At, B1); PG8_BAR;
            PG8_LDB(B0, 1, 0); PG8_SCHED; PG8_LDA(At, 1, 0); PG8_STAGE(PG8_SA(0, 1), a2 + hstepA, voffA);
            PG8_WAIT_L(8); PG8_BAR; PG8_WAIT_L(0); PG8_MMA(0, 0, At, B0); PG8_BAR; PG8_SCHED;
            PG8_LDB(B1, 1, 1); PG8_STAGE(PG8_SB(1, 0), b3, voffB);
            PG8_BAR; PG8_WAIT_L(0); PG8_MMA(0, 1, At, B1); PG8_BAR;
            PG8_LDA(At, 1, 1); PG8_STAGE(PG8_SA(1, 0), a3, voffA);
            PG8_BAR; PG8_WAIT_L(0); PG8_MMA(1, 0, At, B0); PG8_BAR; PG8_SCHED;
            PG8_STAGE(PG8_SB(1, 1), b3 + hstep, voffB);
            PG8_WAIT_V(6); PG8_BAR; PG8_MMA(1, 1, At, B1); PG8_BAR;
            }
        }
        if constexpr (ALIGN_EPI) { if (wr == 0) PG8_BAR; }
        if constexpr (!Epi::AFTER_DRAIN) { E(acc, cur, wr, wc, fr, fq); S.done(cur); }
        if (!has_next) break;
#pragma unroll
        for (int a = 0; a < 2; ++a)
#pragma unroll
            for (int b = 0; b < 2; ++b)
#pragma unroll
                for (int m = 0; m < 4; ++m)
#pragma unroll
                    for (int n = 0; n < 2; ++n) acc[a][b][m][n] = (f32x4){0.f, 0.f, 0.f, 0.f};
        cur = nxt; cA = nA; cB = nB; ++ui;
        if constexpr (ALIGN_EPI) { if (wr == 1) PG8_BAR; }
    }
    PG8_WAIT_V(0);
    if constexpr (!ALIGN_EPI) { if (wr == 0) PG8_BAR; }
    PG8_BAR;
    if constexpr (Epi::AFTER_DRAIN) { E.fused(acc, cur, wr, wc, fr, fq, lds, wid, lane); S.done(cur); }
#undef PG8_SA
#undef PG8_SB
#undef PG8_STAGE
#undef PG8_LDA
#undef PG8_LDB
#undef PG8_MMA
#undef PG8_WAIT_V
#undef PG8_WAIT_L
#undef PG8_BAR
#undef PG8_SCHED
}
}

namespace attn_body {
using bf16=__hip_bfloat16;
using bf16x8=__attribute__((ext_vector_type(8)))short;
using s16x4=__attribute__((ext_vector_type(4)))short;
using f32x16=__attribute__((ext_vector_type(16)))float;
using u32x4=__attribute__((ext_vector_type(4)))unsigned;
using f32x4v=__attribute__((ext_vector_type(4)))float;
__device__ __forceinline__ float bf2f(short v){return __uint_as_float(((unsigned)(unsigned short)v)<<16);}
constexpr int BATCH=8,NHEAD=8,SEQ=2048,D=64,DM=4608;
constexpr int NW=8,QBLK=32,QB=QBLK*NW,KVBLK=64,NQB=SEQ/QB;
constexpr int ATTN_PITCH=DM, ATTN_UNIT_ROWS=QB;
__device__ __forceinline__ int crow(int r,int hi){return (r&3)+8*(r>>2)+4*hi;}
#define SBAR() __builtin_amdgcn_sched_barrier(0)
__device__ __forceinline__ void cmask(f32x16&p0,f32x16&p1,int jb,int qrel,int hi){
  const float NEG=-INFINITY; int kb=64*jb+4*hi;
  #pragma unroll
  for(int r=0;r<16;++r){int kv=kb+(r&3)+8*(r>>2); if(kv>qrel)p0[r]=NEG; if(kv+32>qrel)p1[r]=NEG;}
}

constexpr int NSLOT=3, SLOTB=8192;
constexpr int LDS_K=0, LDS_V=NSLOT*SLOTB, LDS_WS=2*NSLOT*SLOTB, LDS_OST=LDS_WS+NW*64*4, LDS_BYTES=LDS_OST+NW*4096;
constexpr float C2=0.125f*1.4426950408889634f;
__device__ __forceinline__ void glds16(const void*gsrc,unsigned lds_dst){unsigned keep;
  asm volatile("s_mov_b32 %0, m0\n\ts_mov_b32 m0, %2\n\ts_nop 0\n\tglobal_load_lds_dwordx4 %1, off\n\ts_mov_b32 m0, %0":"=&s"(keep):"v"(gsrc),"s"(lds_dst):"memory");}
__device__ __forceinline__ float max3f(float a,float b,float c){float r;asm("v_max3_f32 %0, %1, %2, %3":"=v"(r):"v"(a),"v"(b),"v"(c));return r;}
__device__ __forceinline__ float max2f(float a,float b){float r;asm("v_max_f32_e32 %0, %1, %2":"=v"(r):"v"(a),"v"(b));return r;}
__device__ __forceinline__ float fadd_s(float a,float b){float r;asm("v_add_f32_e32 %0, %1, %2":"=v"(r):"v"(a),"v"(b));return r;}
__device__ __forceinline__ float fsub_s(float a,float b){float r;asm("v_sub_f32_e32 %0, %1, %2":"=v"(r):"v"(a),"v"(b));return r;}
typedef float f32x2_t __attribute__((ext_vector_type(2))); typedef __bf16 bf16x2_t __attribute__((ext_vector_type(2)));
__device__ __forceinline__ unsigned cvtpk_s(float lo,float hi){f32x2_t v={lo,hi};bf16x2_t b=__builtin_convertvector(v,bf16x2_t);return __builtin_bit_cast(unsigned,b);}
#define WAIT_BAR(N) asm volatile("s_waitcnt vmcnt(" #N ") lgkmcnt(0)\n\ts_barrier":::"memory")

__device__ __forceinline__ void qkt(f32x16&p0,f32x16&p1,const char*Kslot,const bf16x8*qr,const f32x16&negm,int r32,int hi){
  const char*kb=Kslot+hi*1024+r32*16;
  #pragma unroll
  for(int d0=0;d0<4;++d0){
    const bf16x8 b0=*reinterpret_cast<const bf16x8*>(kb+d0*2048);
    const bf16x8 b1=*reinterpret_cast<const bf16x8*>(kb+d0*2048+512);
    if(d0==0){p0=__builtin_amdgcn_mfma_f32_32x32x16_bf16(b0,qr[0],negm,0,0,0);p1=__builtin_amdgcn_mfma_f32_32x32x16_bf16(b1,qr[0],negm,0,0,0);}
    else{p0=__builtin_amdgcn_mfma_f32_32x32x16_bf16(b0,qr[d0],p0,0,0,0);p1=__builtin_amdgcn_mfma_f32_32x32x16_bf16(b1,qr[d0],p1,0,0,0);}}
}
typedef __attribute__((address_space(3))) const char* lds_cptr;
typedef short v4i16_t __attribute__((ext_vector_type(4)));
__device__ __forceinline__ void kload8(bf16x8*kf,lds_cptr kp){
  kf[0]=*(const __attribute__((address_space(3))) bf16x8*)(kp);      kf[1]=*(const __attribute__((address_space(3))) bf16x8*)(kp+512);
  kf[2]=*(const __attribute__((address_space(3))) bf16x8*)(kp+2048); kf[3]=*(const __attribute__((address_space(3))) bf16x8*)(kp+2560);
  kf[4]=*(const __attribute__((address_space(3))) bf16x8*)(kp+4096); kf[5]=*(const __attribute__((address_space(3))) bf16x8*)(kp+4608);
  kf[6]=*(const __attribute__((address_space(3))) bf16x8*)(kp+6144); kf[7]=*(const __attribute__((address_space(3))) bf16x8*)(kp+6656);
}
__device__ __forceinline__ void kload2(bf16x8*kf,lds_cptr kp,int j){ kf[2*j]=*(const __attribute__((address_space(3))) bf16x8*)(kp+j*2048); kf[2*j+1]=*(const __attribute__((address_space(3))) bf16x8*)(kp+j*2048+512); }
__device__ __forceinline__ s16x4 vtr(lds_cptr p){ return __builtin_bit_cast(s16x4,__builtin_amdgcn_ds_read_tr16_b64_v4i16((__attribute__((address_space(3))) v4i16_t*)p)); }
__device__ __forceinline__ float rowmax(const f32x16&p0,const f32x16&p1){
  float a=max3f(p0[0],p0[1],p1[0]),b=max3f(p0[2],p0[3],p1[1]);a=max3f(a,p1[2],p1[3]);
  #pragma unroll
  for(int r=4;r<16;r+=4){a=max3f(a,p0[r],p0[r+1]);b=max3f(b,p0[r+2],p0[r+3]);a=max3f(a,p1[r],p1[r+1]);b=max3f(b,p1[r+2],p1[r+3]);}
  const float m=max2f(a,b);
  auto rr=__builtin_amdgcn_permlane32_swap(__float_as_uint(m),__float_as_uint(m),false,false);
  return max2f(__uint_as_float(rr[0]),__uint_as_float(rr[1]));
}
__device__ __forceinline__ void pv(f32x16*o,int vb,bf16x8 pa0,bf16x8 pa1,bf16x8 pa2,bf16x8 pa3){
  #pragma unroll
  for(int d0=0;d0<2;++d0){s16x4 lo[4],hi[4];
    #pragma unroll
    for(int ks=0;ks<4;++ks){
      asm volatile("ds_read_b64_tr_b16 %0,%1 offset:%c2":"=&v"(lo[ks]):"v"(vb),"i"(d0*4096+ks*1024):"memory");
      asm volatile("ds_read_b64_tr_b16 %0,%1 offset:%c2":"=&v"(hi[ks]):"v"(vb),"i"(d0*4096+ks*1024+512):"memory");}
    asm volatile("s_waitcnt lgkmcnt(0)":::"memory");SBAR();
    #define PK(k) (bf16x8){lo[k][0],lo[k][1],lo[k][2],lo[k][3],hi[k][0],hi[k][1],hi[k][2],hi[k][3]}
    o[d0]=__builtin_amdgcn_mfma_f32_32x32x16_bf16(pa0,PK(0),o[d0],0,0,0);
    o[d0]=__builtin_amdgcn_mfma_f32_32x32x16_bf16(pa1,PK(1),o[d0],0,0,0);
    o[d0]=__builtin_amdgcn_mfma_f32_32x32x16_bf16(pa2,PK(2),o[d0],0,0,0);
    o[d0]=__builtin_amdgcn_mfma_f32_32x32x16_bf16(pa3,PK(3),o[d0],0,0,0);
    #undef PK
  }
}

#ifndef ATTN_STORE16
#define ATTN_STORE16(p,v) (*(u32x4*)(p)=(v))
#endif
template<int THRL> __device__ __forceinline__ void attn_unit(int b,int h,int qb,const bf16*Q,const bf16*__restrict__ K,const bf16*__restrict__ V,bf16*O,const float*km,char*shm){
  int tid_l=threadIdx.x; asm volatile("":"+v"(tid_l)); const int tid=tid_l,lane=tid&63,r32=lane&31,hi=lane>>5; const int wid=__builtin_amdgcn_readfirstlane(tid>>6);
  const long rowbase=(long)b*SEQ; const int q0=qb*QB;
  const bf16*Qw=Q+(rowbase+q0+wid*QBLK)*DM+h*D;
  const bf16*Kh=K+rowbase*DM+h*D,*Vh=V+rowbase*DM+h*D;
  const unsigned lds0=(unsigned)(uintptr_t)shm;
  float*wsf=(float*)(shm+LDS_WS)+wid*64;
  const bf16*ksrc=Kh+(long)lane*DM+wid*8;
  const bf16*vsrc=Vh+(long)(16*(wid&3)+(lane>>2))*DM+(wid>>2)*32+(lane&3)*8;
  const unsigned kdst=lds0+LDS_K+wid*1024, vdst=lds0+LDS_V+wid*1024;
  #define DMA_K(t,slot) glds16(ksrc+(long)(t)*KVBLK*DM,(unsigned)__builtin_amdgcn_readfirstlane(kdst+(slot)))
  #define DMA_V(t,slot) glds16(vsrc+(long)(t)*KVBLK*DM,(unsigned)__builtin_amdgcn_readfirstlane(vdst+(slot)))
  const int vb0=(int)(lds0+LDS_V)+((lane>>4)&1)*32+(lane&3)*8+(4*hi+((lane&15)>>2))*64;
  const char*Kbase=shm+LDS_K; bf16x8 kf[8];
  const lds_cptr shm3=(lds_cptr)shm; const lds_cptr kp0=shm3+LDS_K+hi*1024+r32*16; const lds_cptr vp0=shm3+LDS_V+((lane>>4)&1)*32+(lane&3)*8+(4*hi+((lane&15)>>2))*64;
  const int NT=(q0+QB)/KVBLK;
  DMA_K(0,0);DMA_V(0,0);DMA_K(1,SLOTB);
  bf16x8 qr[4];
  #pragma unroll
  for(int d0=0;d0<4;++d0)qr[d0]=*reinterpret_cast<const bf16x8*>(&Qw[(long)r32*DM+d0*16+hi*8]);

  unsigned sel=(1u<<qb)-1u;
  if(qb>3){
    float rt[7];
    #pragma unroll
    for(int j=0;j<7;++j){ float pr=-INFINITY;
      if(j<qb){ const float*kp=km+j*64+8*hi; float s=0.f;
        #pragma unroll
        for(int d0=0;d0<4;++d0){ const f32x4v ka=*(const f32x4v*)(kp+16*d0)+*(const f32x4v*)(kp+32768+16*d0), kb2=*(const f32x4v*)(kp+16*d0+4)+*(const f32x4v*)(kp+32768+16*d0+4);
          s+=bf2f(qr[d0][0])*ka[0]+bf2f(qr[d0][1])*ka[1]+bf2f(qr[d0][2])*ka[2]+bf2f(qr[d0][3])*ka[3]+bf2f(qr[d0][4])*kb2[0]+bf2f(qr[d0][5])*kb2[1]+bf2f(qr[d0][6])*kb2[2]+bf2f(qr[d0][7])*kb2[3]; }
        s+=__shfl_xor(s,32); pr=s; }
      rt[j]=pr; }
    sel=0u;
    #pragma unroll
    for(int j=0;j<7;++j){ int rank=0;
      #pragma unroll
      for(int i=0;i<7;++i){ if(i!=j) rank+=((rt[i]>rt[j])||((rt[i]==rt[j])&&(i<j)))?1:0; }
      if(j<qb&&rank<3) sel|=(1u<<j); }
  }
  const float NEGB=-16384.f;
  float mhat=0.f,l_reg=0.f;f32x16 o[2];o[0]=f32x16{};o[1]=f32x16{};f32x16 negm=f32x16{};asm volatile("":"+v"(negm));
  const int qrel=wid*QBLK+r32;
  #define CMASK(P0,P1,t) do{int jb_=(t)-(NT-4); if(jb_>=0)cmask(P0,P1,jb_,qrel,hi); else if(!((sel>>((t)>>2))&1u)){ _Pragma("unroll") for(int r_=0;r_<16;++r_){P0[r_]=NEGB;P1[r_]=NEGB;} } }while(0)
  bool resc=false;
  #define START(P0,P1) do{ const float rm=rowmax(P0,P1); resc=false; \
    { const float dl=rm; mhat=fadd_s(mhat,dl); \
      _Pragma("unroll") for(int r=0;r<16;++r){P0[r]=fsub_s(P0[r],dl);P1[r]=fsub_s(P1[r],dl);} \
      _Pragma("unroll") for(int r=0;r<16;++r)negm[r]=-mhat; asm volatile("":"+v"(negm)); } \
    _Pragma("unroll") for(int r=0;r<16;++r)P0[r]=__builtin_amdgcn_exp2f(P0[r]); }while(0)
  #define RESC() do{ if(resc){ asm volatile("s_waitcnt lgkmcnt(0)":::"memory"); \
      _Pragma("unroll") for(int d_=0;d_<2;++d_) _Pragma("unroll") for(int r=0;r<16;++r)o[d_][r]*=wsf[crow(r,hi)]; } }while(0)
  f32x16 pA0,pA1,pB0,pB1;
  int sl_prev=0,sl_cur=0,sl_next=SLOTB;
  #define ROT() do{sl_prev=sl_cur;sl_cur=sl_next;sl_next=(sl_next==(NSLOT-1)*SLOTB)?0:sl_next+SLOTB;}while(0)
  DMA_K(2,2*SLOTB);
  WAIT_BAR(3);
  qkt(pA0,pA1,Kbase,qr,negm,r32,hi);asm volatile("s_nop 15\n\ts_nop 7":"+v"(pA0),"+v"(pA1));CMASK(pA0,pA1,0);
  START(pA0,pA1);
  _Pragma("unroll") for(int r=0;r<16;++r)pA1[r]=__builtin_amdgcn_exp2f(pA1[r]);
  WAIT_BAR(0);
  DMA_K(3,0);DMA_V(1,SLOTB);
  ROT();
  kload8(kf,kp0+sl_cur);
  WAIT_BAR(2);
  s16x4 vlo[8],vhi[8]; u32x4 pw0,pw1,pw2,pw3;
  #define PKW(P,B) cvtpk_s(P[B],P[B+1])
  #define PAF(k) __builtin_bit_cast(bf16x8,pw##k)
  #define VFR(i) (bf16x8){vlo[i][0],vlo[i][1],vlo[i][2],vlo[i][3],vhi[i][0],vhi[i][1],vhi[i][2],vhi[i][3]}
  #define PIN(x) asm volatile("":"+v"(x))
  #define MX3(a,b,c) __builtin_fmaxf(__builtin_fmaxf((a),(b)),(c))
  #define GAPA(MF,A0,A1,A2,A3,W0,W1,PW) do{ MF; sacc+=A0; sacc+=A1; sacc+=A2; sacc+=A3; PIN(sacc); W0; W1; PIN(PW); SBAR(); }while(0)
  #define EX(v) __builtin_amdgcn_exp2f(v)
  #define GAPB(MF,X,B) do{ MF; X[B]=EX(X[B]); X[B+1]=EX(X[B+1]); X[B+2]=EX(X[B+2]); X[B+3]=EX(X[B+3]); PIN(X); SBAR(); }while(0)
  #define VRD(i) do{ vlo[i]=vtr(vp_+(((i)>>2)*4096+((i)&3)*1024)); vhi[i]=vtr(vp_+(((i)>>2)*4096+((i)&3)*1024+512)); }while(0)
  #define KRD(G,j) do{ if(G){ kload2(kf,kp0+sl_next,j); SBAR(); } }while(0)
  #define STEP(C0,C1,P0,P1,t,GK,GV,GL) do{ SBAR(); \
    const lds_cptr vp_=vp0+sl_prev; \
    VRD(0); SBAR(); float sacc=(P0[0]+P0[1]); \
    GAPA(C0=__builtin_amdgcn_mfma_f32_32x32x16_bf16(kf[0],qr[0],negm,0,0,0), P0[2],P0[3],P0[4],P0[5],     pw0[0]=PKW(P0,0), pw0[1]=PKW(P0,2), pw0); \
    VRD(4); SBAR(); GAPA(C1=__builtin_amdgcn_mfma_f32_32x32x16_bf16(kf[1],qr[0],negm,0,0,0), P0[6],P0[7],P0[8],P0[9],     pw0[2]=PKW(P0,4), pw0[3]=PKW(P0,6), pw0); \
    VRD(1); SBAR(); GAPA(C0=__builtin_amdgcn_mfma_f32_32x32x16_bf16(kf[2],qr[1],C0,0,0,0),   P0[10],P0[11],P0[12],P0[13], pw1[0]=PKW(P0,8), pw1[1]=PKW(P0,10), pw1); \
    VRD(5); SBAR(); GAPA(C1=__builtin_amdgcn_mfma_f32_32x32x16_bf16(kf[3],qr[1],C1,0,0,0),   P0[14],P0[15],P1[0],P1[1],   pw1[2]=PKW(P0,12),pw1[3]=PKW(P0,14), pw1); \
    VRD(2); SBAR(); GAPA(C0=__builtin_amdgcn_mfma_f32_32x32x16_bf16(kf[4],qr[2],C0,0,0,0),   P1[2],P1[3],P1[4],P1[5],     pw2[0]=PKW(P1,0), pw2[1]=PKW(P1,2), pw2); \
    VRD(6); SBAR(); GAPA(C1=__builtin_amdgcn_mfma_f32_32x32x16_bf16(kf[5],qr[2],C1,0,0,0),   P1[6],P1[7],P1[8],P1[9],     pw2[2]=PKW(P1,4), pw2[3]=PKW(P1,6), pw2); \
    VRD(3); SBAR(); GAPA(C0=__builtin_amdgcn_mfma_f32_32x32x16_bf16(kf[6],qr[3],C0,0,0,0),   P1[10],P1[11],P1[12],P1[13], pw3[0]=PKW(P1,8), pw3[1]=PKW(P1,10), pw3); \
    VRD(7); SBAR(); GAPA(C1=__builtin_amdgcn_mfma_f32_32x32x16_bf16(kf[7],qr[3],C1,0,0,0),   P1[14],P1[15],0.f,0.f,       pw3[2]=PKW(P1,12),pw3[3]=PKW(P1,14), pw3); \
    l_reg+=sacc; \
    if(GK){DMA_K((t)+3,sl_cur);} if(GV){DMA_V((t)+1,sl_next);} \
    CMASK(C0,C1,t); \
    { float a=MX3(C0[0],C0[1],C1[0]),b=MX3(C0[2],C0[3],C1[1]); a=MX3(a,C1[2],C1[3]); \
      _Pragma("unroll") for(int r=4;r<16;r+=4){a=MX3(a,C0[r],C0[r+1]);b=MX3(b,C0[r+2],C0[r+3]);a=MX3(a,C1[r],C1[r+1]);b=MX3(b,C1[r+2],C1[r+3]);} \
      float rm=__builtin_fmaxf(a,b); { auto rr=__builtin_amdgcn_permlane32_swap(__float_as_uint(rm),__float_as_uint(rm),false,false); rm=__builtin_fmaxf(__uint_as_float(rr[0]),__uint_as_float(rr[1])); } \
      resc=false; \
      if(__builtin_expect(__any(rm>(float)THRL),0)){ const float dl=__builtin_fmaxf(rm,0.f); mhat+=dl; \
        _Pragma("unroll") for(int r=0;r<16;++r){C0[r]-=dl;C1[r]-=dl;} \
        _Pragma("unroll") for(int r=0;r<16;++r)negm[r]=-mhat; asm volatile("":"+v"(negm)); \
        const float f=__builtin_amdgcn_exp2f(-dl); l_reg*=f; if(hi==0)wsf[r32]=f; resc=true; } } \
    SBAR(); \
    GAPB(o[0]=__builtin_amdgcn_mfma_f32_32x32x16_bf16(PAF(0),VFR(0),o[0],0,0,0), C0,0); \
    GAPB(o[1]=__builtin_amdgcn_mfma_f32_32x32x16_bf16(PAF(0),VFR(4),o[1],0,0,0), C0,4); \
    KRD(GL,0); GAPB(o[0]=__builtin_amdgcn_mfma_f32_32x32x16_bf16(PAF(1),VFR(1),o[0],0,0,0), C0,8); \
    KRD(GL,1); GAPB(o[1]=__builtin_amdgcn_mfma_f32_32x32x16_bf16(PAF(1),VFR(5),o[1],0,0,0), C0,12); \
    KRD(GL,2); GAPB(o[0]=__builtin_amdgcn_mfma_f32_32x32x16_bf16(PAF(2),VFR(2),o[0],0,0,0), C1,0); \
    KRD(GL,3); GAPB(o[1]=__builtin_amdgcn_mfma_f32_32x32x16_bf16(PAF(2),VFR(6),o[1],0,0,0), C1,4); \
    GAPB(o[0]=__builtin_amdgcn_mfma_f32_32x32x16_bf16(PAF(3),VFR(3),o[0],0,0,0), C1,8); \
    GAPB(o[1]=__builtin_amdgcn_mfma_f32_32x32x16_bf16(PAF(3),VFR(7),o[1],0,0,0), C1,12); \
    }while(0)
  int t=1;
  for(;t+5<NT;t+=2){
    STEP(pB0,pB1,pA0,pA1,t,true,true,true);     WAIT_BAR(2); RESC(); ROT();
    STEP(pA0,pA1,pB0,pB1,t+1,true,true,true);   WAIT_BAR(2); RESC(); ROT();
  }
  #define ENDW(tt) do{ if((tt)+3<NT){WAIT_BAR(2);} else if((tt)+2<NT){WAIT_BAR(1);} else {WAIT_BAR(0);} }while(0)
  for(;t+1<NT;t+=2){
    STEP(pB0,pB1,pA0,pA1,t,(t+3<NT),(t+1<NT),(t+1<NT));       ENDW(t);   RESC(); ROT();
    STEP(pA0,pA1,pB0,pB1,t+1,(t+4<NT),(t+2<NT),(t+2<NT));     ENDW(t+1); RESC(); ROT();
  }
  STEP(pB0,pB1,pA0,pA1,NT-1,false,false,false); RESC();
  { float sacc=pB0[0]+pB0[1]; _Pragma("unroll") for(int r=2;r<16;++r)sacc+=pB0[r]; _Pragma("unroll") for(int r=0;r<16;++r)sacc+=pB1[r]; l_reg+=sacc;
    pw0=(u32x4){PKW(pB0,0),PKW(pB0,2),PKW(pB0,4),PKW(pB0,6)};pw1=(u32x4){PKW(pB0,8),PKW(pB0,10),PKW(pB0,12),PKW(pB0,14)};pw2=(u32x4){PKW(pB1,0),PKW(pB1,2),PKW(pB1,4),PKW(pB1,6)};pw3=(u32x4){PKW(pB1,8),PKW(pB1,10),PKW(pB1,12),PKW(pB1,14)};
    SBAR(); pv(o,vb0+sl_cur,PAF(0),PAF(1),PAF(2),PAF(3)); }
  #undef PKW
  #undef PAF
  #undef VFR
  #undef PIN
  #undef MX3
  #undef GAPA
  #undef GAPB
  #undef EX
  #undef VRD
  #undef KRD
  #undef STEP
  #undef ENDW
  {auto rr=__builtin_amdgcn_permlane32_swap(__float_as_uint(l_reg),__float_as_uint(l_reg),false,false);l_reg=__uint_as_float(rr[0])+__uint_as_float(rr[1]);}
  if(hi==0)wsf[32+r32]=l_reg;asm volatile("s_waitcnt lgkmcnt(0)":::"memory");
  float rli[16];
  #pragma unroll
  for(int r=0;r<16;++r)rli[r]=__builtin_amdgcn_rcpf(wsf[32+crow(r,hi)]);
  bf16*Ow=O+(rowbase+q0+wid*QBLK)*DM+h*D;
  { bf16*stg=(bf16*)(shm+LDS_OST)+wid*2048;
    #pragma unroll
    for(int r=0;r<16;++r){const int orow=crow(r,hi);
      #pragma unroll
      for(int d0=0;d0<2;++d0)stg[orow*64+d0*32+r32]=__float2bfloat16(o[d0][r]*rli[r]);}
    asm volatile("s_waitcnt lgkmcnt(0)":::"memory");
    #pragma unroll
    for(int i=0;i<4;++i){const int row=i*8+(lane>>3),ch=lane&7; const u32x4 v=*(const u32x4*)(stg+row*64+ch*8); ATTN_STORE16(Ow+(long)row*DM+ch*8,v);} }
  asm volatile("s_waitcnt lgkmcnt(0)\n\ts_barrier":::"memory");
  #undef DMA_K
  #undef DMA_V
  #undef CMASK
  #undef START
  #undef RESC
  #undef ROT
}
constexpr int ATTN_LDS_BYTES=LDS_BYTES;
#undef SBAR
#undef WAIT_BAR
}

#define GAS __attribute__((address_space(1)))
#define LAS __attribute__((address_space(3)))
typedef unsigned short bf16;
typedef unsigned v4u __attribute__((ext_vector_type(4)));
typedef unsigned v2u __attribute__((ext_vector_type(2)));
typedef float f32x4 __attribute__((ext_vector_type(4)));
typedef short bf16x8 __attribute__((ext_vector_type(8)));
#define LDS_WAIT() asm volatile("s_waitcnt lgkmcnt(0)" ::: "memory")
__device__ __forceinline__ unsigned f2bf(float f) { unsigned u = __builtin_bit_cast(unsigned, f); return (u + 0x7fffu + ((u >> 16) & 1u)) >> 16; }
__device__ __forceinline__ unsigned pk2(float lo, float hi) { return f2bf(lo) | (f2bf(hi) << 16); }

constexpr int NWAVES = 8;
constexpr int DMODEL = 1024, NBATCH = 8, SEQL = 2048, MROWS = NBATCH * SEQL, NLAYER = 4;
constexpr int INW = 4608, DFF = 2816, UPW = 2 * DFF, NMODW = 6 * DMODEL;
constexpr int COL_Q = 0, COL_K = 512, COL_V = 1024, COL_U = 1536, COL_VS = 2048, COL_GA = 2560, COL_GS = 3584;
constexpr float RMS_EPS = 1e-6f;

constexpr size_t MiB = 1u << 20;
constexpr size_t WS_MOD = 0, WS_KMS = 1 * MiB;
constexpr size_t WS_WIN = 2 * MiB;
constexpr size_t WS_WA = 11 * MiB;
constexpr size_t WS_WS = 12 * MiB;
constexpr size_t WS_WO = 13 * MiB;
constexpr size_t WS_WUP = 15 * MiB;
constexpr size_t WS_WDN = 26 * MiB;
constexpr size_t WS_WSG = 31 * MiB + 512 * 1024;
constexpr size_t WS_R1 = 32 * MiB;
constexpr size_t WS_G = 208 * MiB;
constexpr size_t WS_H = WS_G, WS_MG = WS_G + 32 * MiB;
constexpr size_t WS_END = 296 * MiB;

constexpr int RING_BYTES = 131072;
constexpr int LDS_BYTES = 147456;
constexpr int LDS_MISC = RING_BYTES;

__device__ __forceinline__ float wave_sum(float v) {
#pragma unroll
    for (int o = 1; o < 64; o <<= 1) v += __shfl_xor(v, o);
    return v;
}

__device__ __forceinline__ void transpose_item(const float* W, int K, int N, bf16* WT, LAS float* scr, int item, int lane) {
    const int nblk = N / 32, kb = item / nblk, nb = item % nblk, k0 = 64 * kb, n0 = 32 * nb;
#pragma unroll 8
    for (int i = 0; i < 32; ++i) { const int kk = 2 * i + (lane >> 5); scr[kk * 33 + (lane & 31)] = W[(size_t)(k0 + kk) * N + n0 + (lane & 31)]; }
    LDS_WAIT(); asm volatile("" ::: "memory");
    const int c = lane & 7;
#pragma unroll
    for (int j = 0; j < 4; ++j) { const int n = (lane >> 3) + 8 * j; const LAS float* s = scr + (8 * c) * 33 + n;
        v4u o; o.x = pk2(s[0 * 33], s[1 * 33]); o.y = pk2(s[2 * 33], s[3 * 33]); o.z = pk2(s[4 * 33], s[5 * 33]); o.w = pk2(s[6 * 33], s[7 * 33]);
        *(v4u*)(WT + (size_t)(n0 + n) * K + k0 + 8 * c) = o; }
    LDS_WAIT(); asm volatile("" ::: "memory");
}

__device__ __forceinline__ void norm_mod_row(const float* xrow, const float* g, const float* sc, const float* sh, bf16* orow, int lane) {
    f32x4 v[4]; float s = 0.f;
#pragma unroll
    for (int j = 0; j < 4; ++j) { v[j] = *(const f32x4*)(xrow + 4 * lane + 256 * j); s += (v[j].x * v[j].x + v[j].y * v[j].y) + (v[j].z * v[j].z + v[j].w * v[j].w); }
    const float rstd = 1.0f / sqrtf(wave_sum(s) * (1.0f / DMODEL) + RMS_EPS);
#pragma unroll
    for (int j = 0; j < 4; ++j) { const int c = 4 * lane + 256 * j;
        const f32x4 g4 = *(const f32x4*)(g + c), s4 = *(const f32x4*)(sc + c), h4 = *(const f32x4*)(sh + c);
        const f32x4 y = (v[j] * rstd * g4) * (s4 + 1.0f) + h4;
        v2u o; o.x = pk2(y.x, y.y); o.y = pk2(y.z, y.w); *(v2u*)(orow + c) = o; }
}
__device__ __forceinline__ void norm_final_row(const float* xrow, const float* g, float* orow, int lane) {
    f32x4 v[4]; float s = 0.f;
#pragma unroll
    for (int j = 0; j < 4; ++j) { v[j] = *(const f32x4*)(xrow + 4 * lane + 256 * j); s += (v[j].x * v[j].x + v[j].y * v[j].y) + (v[j].z * v[j].z + v[j].w * v[j].w); }
    const float rstd = 1.0f / sqrtf(wave_sum(s) * (1.0f / DMODEL) + RMS_EPS);
#pragma unroll
    for (int j = 0; j < 4; ++j) { const int c = 4 * lane + 256 * j; const f32x4 g4 = *(const f32x4*)(g + c); *(f32x4*)(orow + c) = v[j] * rstd * g4; }
}

__device__ __forceinline__ void phase_mod(const float* c, const float* w_mod, float* modp, LAS float* cact, int tid, int lane, int gw, int NGW) {
    for (int i = tid; i < NBATCH * DMODEL; i += NWAVES * 64) { const float v = c[i]; cact[i] = v / (1.0f + __expf(-v)); }
    __syncthreads();
    for (int it = gw; it < 96 * 16; it += NGW) {
        const int cgp = it % 96, kc = it / 96, l = cgp / 24, n0 = (cgp % 24) * 256 + 4 * lane;
        const float* wp = w_mod + ((size_t)l * DMODEL + kc * 64) * NMODW + n0;
        f32x4 acc[8];
#pragma unroll
        for (int b = 0; b < 8; ++b) acc[b] = (f32x4){0.f, 0.f, 0.f, 0.f};
#pragma unroll 8
        for (int k = 0; k < 64; ++k) { const f32x4 w = *(const f32x4*)(wp + (size_t)k * NMODW);
#pragma unroll
            for (int b = 0; b < 8; ++b) acc[b] += w * cact[b * DMODEL + kc * 64 + k]; }
#pragma unroll
        for (int b = 0; b < 8; ++b) *(f32x4*)(modp + ((size_t)(kc * 32 + l * 8 + b)) * NMODW + n0) = acc[b];
    }
}

__device__ __forceinline__ void phase_mod_reduce(const float* modp, const float* b_mod, float* mod, int gtid, int NGT) {
    for (int i4 = gtid; i4 < NLAYER * 8 * NMODW / 4; i4 += NGT) { const int i = i4 * 4, lb = i / NMODW, n = i % NMODW, l = lb >> 3;
        f32x4 s = *(const f32x4*)(b_mod + (size_t)l * NMODW + n);
#pragma unroll
        for (int kc = 0; kc < 16; ++kc) s += *(const f32x4*)(modp + ((size_t)(kc * 32 + lb)) * NMODW + n);
        *(f32x4*)(mod + i) = s; }
}

__device__ __forceinline__ void sgu_unit(int unit, bf16* P, const float* g_sgu, const bf16* Wsm, const float* b_s, LAS unsigned char* lds, int tid, int lane, int wave) {
    const int ihalf = unit & 1, bc = unit >> 1;
    const size_t row0 = (size_t)bc * 128;
    const int jmax = ihalf ? 128 : 64;
    LAS float* rstd = (LAS float*)(lds + LDS_MISC);
    for (int tt = 0; tt < 16; ++tt) { const int tok = wave * 16 + tt;
        const v4u w = *(const v4u*)(P + (row0 + tok) * INW + COL_VS + 8 * lane);
        float s = 0.f;
#pragma unroll
        for (int i = 0; i < 4; ++i) { const float a = pg8::bf_lo(w[i]), b2 = pg8::bf_hi(w[i]); s += a * a + b2 * b2; }
        s = wave_sum(s);
        if (lane == 0) rstd[tok] = 1.0f / sqrtf(s * (1.0f / 512.0f) + RMS_EPS);
    }
    __syncthreads();
    const int g = wave;
    LAS unsigned char* vt = lds + g * 16384;
    { const int c0 = (lane & 7) * 8; float gs[8];
#pragma unroll
        for (int e = 0; e < 8; ++e) gs[e] = g_sgu[g * 64 + c0 + e];
        for (int it = 0; it < jmax / 8; ++it) { const int j = it * 8 + (lane >> 3);
            const v4u w = *(const v4u*)(P + (row0 + j) * INW + COL_VS + g * 64 + c0);
            const float r = rstd[j];
#pragma unroll
            for (int e = 0; e < 8; ++e) { const float x = (e & 1) ? pg8::bf_hi(w[e >> 1]) : pg8::bf_lo(w[e >> 1]); const int c = c0 + e;
                *(LAS unsigned short*)(vt + c * 256 + ((((j >> 3) ^ (c & 15)) << 4) | ((j & 7) * 2))) = (unsigned short)f2bf(x * r * gs[e]); }
        }
    }
    LDS_WAIT(); asm volatile("" ::: "memory");
    f32x4 acc[4][4];
#pragma unroll
    for (int a = 0; a < 4; ++a)
#pragma unroll
        for (int b = 0; b < 4; ++b) acc[a][b] = (f32x4){0.f, 0.f, 0.f, 0.f};
    const int l15 = lane & 15, kq = lane >> 4;
    const bf16* Wg = Wsm + (size_t)g * 128 * 128;
    for (int ks = 0; ks < jmax / 32; ++ks) {
        bf16x8 af[4];
#pragma unroll
        for (int ct = 0; ct < 4; ++ct) { const int c = ct * 16 + l15; af[ct] = *(const LAS bf16x8*)(vt + c * 256 + (((ks * 4 + kq) ^ (c & 15)) << 4)); }
#pragma unroll
        for (int it = 0; it < 4; ++it) { const int itg = ihalf * 4 + it;
            if (32 * ks <= 16 * itg + 15) {
                const bf16x8 bfr = *(const bf16x8*)(Wg + (size_t)(itg * 16 + l15) * 128 + ks * 32 + 8 * kq);
#pragma unroll
                for (int ct = 0; ct < 4; ++ct) acc[it][ct] = __builtin_amdgcn_mfma_f32_16x16x32_bf16(af[ct], bfr, acc[it][ct], 0, 0, 0);
            } }
    }
#pragma unroll
    for (int it = 0; it < 4; ++it) { const int i = (ihalf * 4 + it) * 16 + l15; const float bias = b_s[g * 128 + i];
#pragma unroll
        for (int ct = 0; ct < 4; ++ct) { bf16* up = P + (row0 + i) * INW + COL_U + g * 64 + ct * 16 + 4 * kq;
            const v2u uw = *(const v2u*)up; const f32x4 d = acc[it][ct];
            v2u o; o.x = pk2(pg8::bf_lo(uw.x) * (d[0] + bias), pg8::bf_hi(uw.x) * (d[1] + bias)); o.y = pk2(pg8::bf_lo(uw.y) * (d[2] + bias), pg8::bf_hi(uw.y) * (d[3] + bias));
            *(v2u*)up = o; } }
    __syncthreads();
}

__device__ __forceinline__ void phase_conv(const bf16* U, const float* w_conv, const float* b_conv, bf16* Gb, int gtid, int NGT) {
    for (int idx = gtid; idx < (MROWS / 16) * (DFF / 8); idx += NGT) {
        const int rc = idx / (DFF / 8), cc = idx % (DFF / 8), c0 = cc * 8, t0 = rc * 16;
        float w0[16], w1[16], w2[16], bb[16], p1[16], p2[16];
#pragma unroll
        for (int hsel = 0; hsel < 2; ++hsel)
#pragma unroll
            for (int q = 0; q < 2; ++q) { const int col = hsel * DFF + c0 + 4 * q;
                const f32x4 a = *(const f32x4*)(w_conv + col), b = *(const f32x4*)(w_conv + UPW + col), c = *(const f32x4*)(w_conv + 2 * UPW + col), d = *(const f32x4*)(b_conv + col);
#pragma unroll
                for (int i = 0; i < 4; ++i) { w0[hsel * 8 + q * 4 + i] = a[i]; w1[hsel * 8 + q * 4 + i] = b[i]; w2[hsel * 8 + q * 4 + i] = c[i]; bb[hsel * 8 + q * 4 + i] = d[i]; } }
        const bool first = (t0 & (SEQL - 1)) == 0;
#pragma unroll
        for (int hsel = 0; hsel < 2; ++hsel) {
            v4u a = (v4u){0u, 0u, 0u, 0u}, b = (v4u){0u, 0u, 0u, 0u};
            if (!first) { a = *(const v4u*)(U + (size_t)(t0 - 2) * UPW + hsel * DFF + c0); b = *(const v4u*)(U + (size_t)(t0 - 1) * UPW + hsel * DFF + c0); }
#pragma unroll
            for (int i = 0; i < 4; ++i) { p2[hsel * 8 + 2 * i] = pg8::bf_lo(a[i]); p2[hsel * 8 + 2 * i + 1] = pg8::bf_hi(a[i]); p1[hsel * 8 + 2 * i] = pg8::bf_lo(b[i]); p1[hsel * 8 + 2 * i + 1] = pg8::bf_hi(b[i]); }
        }
#pragma unroll 2
        for (int t = 0; t < 16; ++t) {
            const v4u ua = *(const v4u*)(U + (size_t)(t0 + t) * UPW + c0), ul = *(const v4u*)(U + (size_t)(t0 + t) * UPW + DFF + c0);
            float cur[16], o[8];
#pragma unroll
            for (int i = 0; i < 4; ++i) { cur[2 * i] = pg8::bf_lo(ua[i]); cur[2 * i + 1] = pg8::bf_hi(ua[i]); cur[8 + 2 * i] = pg8::bf_lo(ul[i]); cur[8 + 2 * i + 1] = pg8::bf_hi(ul[i]); }
#pragma unroll
            for (int i = 0; i < 8; ++i) {
                const float a = bb[i] + w2[i] * cur[i] + w1[i] * p1[i] + w0[i] * p2[i];
                const float li = bb[8 + i] + w2[8 + i] * cur[8 + i] + w1[8 + i] * p1[8 + i] + w0[8 + i] * p2[8 + i];
                o[i] = a * pg8::fast_sigmoid(a) * li; }
#pragma unroll
            for (int i = 0; i < 16; ++i) { p2[i] = p1[i]; p1[i] = cur[i]; }
            v4u w; w.x = pk2(o[0], o[1]); w.y = pk2(o[2], o[3]); w.z = pk2(o[4], o[5]); w.w = pk2(o[6], o[7]);
            *(v4u*)(Gb + (size_t)(t0 + t) * DFF + c0) = w;
        }
    }
}

struct Args { const float* in[18]; float* out; unsigned char* ws; };

__global__ void __launch_bounds__(NWAVES * 64, 2) fwd_mega(Args args) {
    extern __shared__ __attribute__((aligned(16))) unsigned char lds_raw[];
    cg::grid_group grid = cg::this_grid();
    LAS unsigned char* lds = (LAS unsigned char*)lds_raw;
    const int G = gridDim.x, NGW = G * NWAVES;
#define GRID_SYNC() do { asm volatile("s_waitcnt vmcnt(0) lgkmcnt(0)" ::: "memory"); grid.sync(); __builtin_amdgcn_fence(__ATOMIC_ACQUIRE, "agent"); asm volatile("s_waitcnt vmcnt(0)" ::: "memory"); } while (0)
#define PHASE_IDS int tid = threadIdx.x; asm volatile("" : "+v"(tid)); const int lane = tid & 63, wave = __builtin_amdgcn_readfirstlane(tid >> 6), gw = blockIdx.x * NWAVES + wave; (void)lane; (void)gw;
    unsigned char* ws = args.ws;
    float* mod = (float*)(ws + WS_MOD);
    float* X = args.out;
    bf16* Wt_in = (bf16*)(ws + WS_WIN); bf16* Wt_a = (bf16*)(ws + WS_WA); bf16* Wt_s = (bf16*)(ws + WS_WS); bf16* Wt_o = (bf16*)(ws + WS_WO);
    bf16* Wt_up = (bf16*)(ws + WS_WUP); bf16* Wt_dn = (bf16*)(ws + WS_WDN); bf16* Wsm = (bf16*)(ws + WS_WSG);
    bf16* P = (bf16*)(ws + WS_R1); bf16* U = (bf16*)(ws + WS_R1); bf16* Gb = (bf16*)(ws + WS_G); bf16* H = (bf16*)(ws + WS_H); bf16* MG = (bf16*)(ws + WS_MG);

    { PHASE_IDS phase_mod(args.in[1], args.in[2], (float*)(ws + WS_R1), (LAS float*)lds, tid, lane, gw, NGW); }
    GRID_SYNC();
    { PHASE_IDS phase_mod_reduce((const float*)(ws + WS_R1), args.in[3], mod, blockIdx.x * (NWAVES * 64) + tid, G * NWAVES * 64); }
    GRID_SYNC();

#pragma unroll 1
    for (int l = 0; l < NLAYER; ++l) {
        const float* modl = mod + (size_t)l * 8 * NMODW;
        const float* Xin = (l == 0) ? args.in[0] : X;
        float* kms = (float*)(ws + WS_KMS) + (size_t)l * 65536;
        {
            PHASE_IDS
            LAS float* scr = (LAS float*)(lds + wave * 16384);
            const float* w_in = args.in[5] + (size_t)l * DMODEL * INW; const float* w_a = args.in[9] + (size_t)l * 512 * DMODEL; const float* w_s = args.in[10] + (size_t)l * 512 * DMODEL;
            const float* w_o = args.in[11] + (size_t)l * DMODEL * DMODEL; const float* w_up = args.in[13] + (size_t)l * DMODEL * UPW; const float* w_dn = args.in[16] + (size_t)l * DFF * DMODEL;
            constexpr int I_IN = (DMODEL / 64) * (INW / 32), I_A = (512 / 64) * (DMODEL / 32), I_O = (DMODEL / 64) * (DMODEL / 32), I_UP = (DMODEL / 64) * (UPW / 32), I_DN = (DFF / 64) * (DMODEL / 32);
            constexpr int NITEMS = I_IN + 2 * I_A + I_O + I_UP + I_DN;
            for (int it = gw; it < NITEMS; it += NGW) {
                int r = it;
                if (r < I_IN) { transpose_item(w_in, DMODEL, INW, Wt_in, scr, r, lane); continue; } r -= I_IN;
                if (r < I_A) { transpose_item(w_a, 512, DMODEL, Wt_a, scr, r, lane); continue; } r -= I_A;
                if (r < I_A) { transpose_item(w_s, 512, DMODEL, Wt_s, scr, r, lane); continue; } r -= I_A;
                if (r < I_O) { transpose_item(w_o, DMODEL, DMODEL, Wt_o, scr, r, lane); continue; } r -= I_O;
                if (r < I_UP) { transpose_item(w_up, DMODEL, UPW, Wt_up, scr, r, lane); continue; } r -= I_UP;
                transpose_item(w_dn, DFF, DMODEL, Wt_dn, scr, r, lane);
            }
            const float* wsg = args.in[7] + (size_t)l * 8 * 128 * 128;
            for (int ch = blockIdx.x * (NWAVES * 64) + tid; ch < 8 * 128 * 16; ch += G * NWAVES * 64) {
                const int i = (ch >> 4) & 127, j0 = (ch & 15) * 8;
                const f32x4 a = *(const f32x4*)(wsg + (size_t)ch * 8), b = *(const f32x4*)(wsg + (size_t)ch * 8 + 4);
                float v[8] = {a[0], a[1], a[2], a[3], b[0], b[1], b[2], b[3]};
#pragma unroll
                for (int e = 0; e < 8; ++e) if (j0 + e > i) v[e] = 0.f;
                v4u o; o.x = pk2(v[0], v[1]); o.y = pk2(v[2], v[3]); o.z = pk2(v[4], v[5]); o.w = pk2(v[6], v[7]);
                *(v4u*)(Wsm + (size_t)ch * 8) = o;
            }
            const float* gmix = args.in[4] + (size_t)l * DMODEL;
            for (int m = gw; m < MROWS; m += NGW) { const float* mb = modl + (size_t)(m >> 11) * NMODW;
                norm_mod_row(Xin + (size_t)m * DMODEL, gmix, mb + DMODEL, mb, H + (size_t)m * DMODEL, lane); }
        }
        GRID_SYNC();
        {
            pg8::Gemm g{H, Wt_in, MROWS, INW, DMODEL, DMODEL}; pg8::StaticOrder S; S.init(MROWS, INW, G, (int)blockIdx.x);
            pg8::EpiIn E{P, kms};
            pg8::gemm_phase<pg8::EpiIn, pg8::StaticOrder, true, true>(lds, g, S, E);
        }
        GRID_SYNC();
        {
            for (int i = blockIdx.x; i < 256; i += G) {
                const int bh = i >> 2, s = i & 3;
#pragma unroll 1
                for (int k = 0; k < 2; ++k) { const int qb = k ? s : 7 - s;
                    attn_body::attn_unit<8>(bh >> 3, bh & 7, qb, (const attn_body::bf16*)(P + COL_Q), (const attn_body::bf16*)(P + COL_K), (const attn_body::bf16*)(P + COL_V), (attn_body::bf16*)(P + COL_Q),
                                            kms + (size_t)bh * 512, (char*)lds_raw); }
            }
            __syncthreads();
            PHASE_IDS
            const float* gsgu = args.in[6] + (size_t)l * 512; const float* bs = args.in[8] + (size_t)l * 8 * 128;
            for (int i = blockIdx.x; i < 256; i += G) sgu_unit(i, P, gsgu, Wsm, bs, lds, tid, lane, wave);
        }
        GRID_SYNC();
#pragma unroll 1
        for (int br = 0; br < 2; ++br) {
            pg8::Gemm g{br ? P + COL_U : P + COL_Q, br ? Wt_s : Wt_a, MROWS, DMODEL, 512, INW}; pg8::StaticOrder S; S.init(MROWS, DMODEL, G, (int)blockIdx.x);
            pg8::EpiBranch E{br ? P + COL_GS : P + COL_GA, MG, br};
            pg8::gemm_phase<pg8::EpiBranch, pg8::StaticOrder, true, true>(lds, g, S, E);
            GRID_SYNC();
        }
        {
            pg8::Gemm g{MG, Wt_o, MROWS, DMODEL, DMODEL, DMODEL}; pg8::StaticOrder S; S.init(MROWS, DMODEL, G, (int)blockIdx.x);
            pg8::EpiRes E{Xin, X, modl + 2 * DMODEL};
            pg8::gemm_phase<pg8::EpiRes, pg8::StaticOrder, true, true>(lds, g, S, E);
        }
        GRID_SYNC();
        {
            PHASE_IDS
            const float* gffn = args.in[12] + (size_t)l * DMODEL;
            for (int m = gw; m < MROWS; m += NGW) { const float* mb = modl + (size_t)(m >> 11) * NMODW;
                norm_mod_row(X + (size_t)m * DMODEL, gffn, mb + 4 * DMODEL, mb + 3 * DMODEL, H + (size_t)m * DMODEL, lane); }
        }
        GRID_SYNC();
        {
            pg8::Gemm g{H, Wt_up, MROWS, UPW, DMODEL, DMODEL}; pg8::StaticOrder S; S.init(MROWS, UPW, G, (int)blockIdx.x);
            pg8::EpiPlain E{U, UPW};
            pg8::gemm_phase<pg8::EpiPlain, pg8::StaticOrder, true, true>(lds, g, S, E);
        }
        GRID_SYNC();
        { PHASE_IDS phase_conv(U, args.in[14] + (size_t)l * 3 * UPW, args.in[15] + (size_t)l * UPW, Gb, blockIdx.x * (NWAVES * 64) + tid, G * NWAVES * 64); }
        GRID_SYNC();
        {
            pg8::Gemm g{Gb, Wt_dn, MROWS, DMODEL, DFF, DFF}; pg8::StaticOrder S; S.init(MROWS, DMODEL, G, (int)blockIdx.x);
            pg8::EpiRes E{X, X, modl + 5 * DMODEL};
            pg8::gemm_phase<pg8::EpiRes, pg8::StaticOrder, true, true>(lds, g, S, E);
        }
        GRID_SYNC();
    }
    { PHASE_IDS for (int m = gw; m < MROWS; m += NGW) norm_final_row(X + (size_t)m * DMODEL, args.in[17], X + (size_t)m * DMODEL, lane); }
}

extern "C" void kernel_launch(void* const* d_in, const int* in_sizes, int n_in, void* d_out, int out_size, void* d_ws, size_t ws_size, hipStream_t stream) {
    static int grid = 0;
    if (grid == 0) {
        if (n_in != 18 || in_sizes[0] != MROWS * DMODEL || out_size != MROWS * DMODEL || ws_size < WS_END) {
            fprintf(stderr, "kernel_launch: unexpected shapes (n_in %d, in0 %d, out %d, ws %zu); nothing launched\n", n_in, n_in > 0 ? in_sizes[0] : -1, out_size, ws_size); grid = -1; return; }
        int dev = 0, cus = 0, per_cu = 0;
        hipGetDevice(&dev); hipDeviceGetAttribute(&cus, hipDeviceAttributeMultiprocessorCount, dev);
        if (hipFuncSetAttribute((const void*)fwd_mega, hipFuncAttributeMaxDynamicSharedMemorySize, LDS_BYTES) != hipSuccess) { fprintf(stderr, "kernel_launch: hipFuncSetAttribute failed\n"); grid = -1; return; }
        if (hipOccupancyMaxActiveBlocksPerMultiprocessor(&per_cu, (const void*)fwd_mega, NWAVES * 64, LDS_BYTES) != hipSuccess || per_cu < 1) { fprintf(stderr, "kernel_launch: occupancy query gave %d\n", per_cu); per_cu = 1; }
        (void)hipGetLastError();
        grid = cus * per_cu;
        fprintf(stderr, "kernel_launch: grid %d (%d CUs x %d)\n", grid, cus, per_cu);
    }
    if (grid < 0) return;
    Args a{};
    for (int i = 0; i < 18; ++i) a.in[i] = (const float*)d_in[i];
    a.out = (float*)d_out; a.ws = (unsigned char*)d_ws;
    void* kargs[] = {&a};
    hipError_t e = hipLaunchCooperativeKernel((const void*)fwd_mega, dim3(grid), dim3(NWAVES * 64), kargs, LDS_BYTES, stream);
    if (e != hipSuccess) fprintf(stderr, "kernel_launch: cooperative launch failed: %s (grid %d)\n", hipGetErrorString(e), grid);
}
```

```cpp
#include <hip/hip_runtime.h>
#include <hip/hip_cooperative_groups.h>
#include <hip/hip_bf16.h>
#include <cstdio>
#include <cstdint>
#include <cmath>
namespace cg = cooperative_groups;
namespace pg8 {
#define PG8_LAS __attribute__((address_space(3)))
typedef unsigned short bf16_t;
typedef short bf16x8 __attribute__((ext_vector_type(8)));
typedef float f32x4 __attribute__((ext_vector_type(4)));
typedef unsigned u32x4 __attribute__((ext_vector_type(4)));
constexpr int BM = 256, BK = 64, HALF = 128, HTB = HALF * BK * 2  , STAGE_BYTES = 8 * HTB, NXCD = 8, WGM = 8;

__host__ __device__ __forceinline__ int lds_byte(int r, int c) { const int st = (r >> 4) * 2 + (c >> 5), rr = r & 15, cc = c & 31, ob = rr * 64 + cc * 2; return st * 1024 + (ob ^ (((ob >> 9) & 1) << 5)); }
__host__ __device__ __forceinline__ void stage_rc(int b, int& R, int& C) { const int st = b / 1024, sb = b % 1024, swz = sb ^ (((sb >> 9) & 1) << 5); R = (st >> 1) * 16 + swz / 64; C = (st & 1) * 32 + (swz % 64) / 2; }
__host__ __device__ __forceinline__ int perm32(int rho) { const int n = rho >> 4, i = rho & 15; return 8 * (i >> 2) + 4 * n + (i & 3); }

struct Unit { int pm, pn; };
struct Gemm { const bf16_t* A; const bf16_t* Bt; int M, N, K, lda; };

struct StaticOrder {
    int nM, nN, nwg, G, c;
    __host__ __device__ void init(int M, int N, int G_, int c_) { nM = M / BM; nN = N / BM; nwg = nM * nN; G = G_; c = c_; }
    __host__ __device__ bool next(int i, Unit& u) const {
        const long L = (long)i * G + c; if (L >= nwg) return false;
        int wgid = (int)L; { const int q = nwg / NXCD, r = nwg % NXCD, xcd = wgid % NXCD, off = wgid / NXCD; wgid = (xcd < r ? xcd * (q + 1) : r * (q + 1) + (xcd - r) * q) + off; }
        const int nig = WGM * nN, gid = wgid / nig, fm = gid * WGM, gsz = (nM - fm) < WGM ? (nM - fm) : WGM;
        u.pm = fm + ((wgid % nig) % gsz); u.pn = (wgid % nig) / gsz; return true;
    }
    __device__ __forceinline__ void a_ready(const Unit&) const {}
    __device__ __forceinline__ void done(const Unit&) const {}
};

__device__ __forceinline__ unsigned cvt_pk_bf16(float lo, float hi) { unsigned r; asm volatile("v_cvt_pk_bf16_f32 %0, %1, %2" : "=v"(r) : "v"(lo), "v"(hi)); return r; }
typedef float f32x2 __attribute__((ext_vector_type(2)));
__device__ __forceinline__ float fast_sigmoid(float x) { return __builtin_amdgcn_rcpf(1.0f + __builtin_amdgcn_exp2f(-1.4426950408889634f * x)); }
__device__ __forceinline__ float gelu_tanh(float x) { const float z2 = 1.5957691216057308f * (x + 0.044715f * x * x * x); return x * fast_sigmoid(z2); }
__device__ __forceinline__ float bf_lo(unsigned w) { return __uint_as_float(w << 16); }
__device__ __forceinline__ float bf_hi(unsigned w) { return __uint_as_float(w & 0xffff0000u); }
constexpr float QSCALE = 0.125f * 1.4426950408889634f;

struct EpiIn {
    static constexpr bool PERM = true, AFTER_DRAIN = false;
    bf16_t* P; float* kms;
    __device__ __forceinline__ void operator()(const f32x4 (&acc)[2][2][4][2], const Unit& u, int wr, int wc, int fr, int fq) const {
        const int pn = u.pn;
        const int row0 = u.pm * BM + wr * 64 + fr, col0 = pn * BM + wc * 32 + 8 * fq;
        f32x4 ks[2][2];
#pragma unroll
        for (int a = 0; a < 2; ++a)
#pragma unroll
            for (int b = 0; b < 2; ++b) ks[a][b] = (f32x4){0.f, 0.f, 0.f, 0.f};
#pragma unroll
        for (int ai = 0; ai < 2; ++ai)
#pragma unroll
            for (int m = 0; m < 4; ++m) { bf16_t* rowp = P + (size_t)(row0 + ai * HALF + m * 16) * 4608 + col0;
#pragma unroll
                for (int bj = 0; bj < 2; ++bj) { f32x4 v0 = acc[ai][bj][m][0], v1 = acc[ai][bj][m][1];
                    if (pn < 2) { v0 = v0 * QSCALE; v1 = v1 * QSCALE; }
                    else if (pn < 4) { ks[bj][0] += v0; ks[bj][1] += v1; }
                    else if (pn < 6) { }
                    else if (pn < 10) {
#pragma unroll
                        for (int i = 0; i < 4; ++i) { v0[i] = gelu_tanh(v0[i]); v1[i] = gelu_tanh(v1[i]); } }
                    else {
#pragma unroll
                        for (int i = 0; i < 4; ++i) { v0[i] = fast_sigmoid(v0[i]); v1[i] = fast_sigmoid(v1[i]); } }
                    u32x4 w; w.x = cvt_pk_bf16(v0[0], v0[1]); w.y = cvt_pk_bf16(v0[2], v0[3]); w.z = cvt_pk_bf16(v1[0], v1[1]); w.w = cvt_pk_bf16(v1[2], v1[3]);
                    *(u32x4*)(rowp + bj * HALF) = w; } }
        if (pn >= 2 && pn < 4) {
            const int b = u.pm >> 3, blk = u.pm & 7;
#pragma unroll
            for (int bj = 0; bj < 2; ++bj)
#pragma unroll
                for (int n = 0; n < 2; ++n)
#pragma unroll
                    for (int i = 0; i < 4; ++i) { float s = ks[bj][n][i];
                        s += __shfl_xor(s, 1); s += __shfl_xor(s, 2); s += __shfl_xor(s, 4); s += __shfl_xor(s, 8);
                        if (fr == 0) { const int kc = (pn - 2) * 256 + bj * 128 + wc * 32 + 8 * fq + 4 * n + i; const int h = kc >> 6, d = kc & 63;
                            kms[(size_t)wr * 32768 + ((size_t)((b * 8 + h) * 8 + blk)) * 64 + d] = s; } }
        }
    }
};

struct EpiBranch {
    static constexpr bool PERM = true, AFTER_DRAIN = false;
    const bf16_t* Gt; bf16_t* Mg; int accum;
    __device__ __forceinline__ void operator()(const f32x4 (&acc)[2][2][4][2], const Unit& u, int wr, int wc, int fr, int fq) const {
        const int row0 = u.pm * BM + wr * 64 + fr, col0 = u.pn * BM + wc * 32 + 8 * fq;
#pragma unroll
        for (int ai = 0; ai < 2; ++ai)
#pragma unroll
            for (int m = 0; m < 4; ++m) { const size_t row = (size_t)(row0 + ai * HALF + m * 16);
#pragma unroll
                for (int bj = 0; bj < 2; ++bj) { const int col = col0 + bj * HALF;
                    const u32x4 g = *(const u32x4*)(Gt + row * 4608 + col);
                    const f32x4 a0 = acc[ai][bj][m][0], a1 = acc[ai][bj][m][1];
                    float o0 = bf_lo(g.x) * a0[0], o1 = bf_hi(g.x) * a0[1], o2 = bf_lo(g.y) * a0[2], o3 = bf_hi(g.y) * a0[3];
                    float o4 = bf_lo(g.z) * a1[0], o5 = bf_hi(g.z) * a1[1], o6 = bf_lo(g.w) * a1[2], o7 = bf_hi(g.w) * a1[3];
                    bf16_t* mp = Mg + row * 1024 + col;
                    if (accum) { const u32x4 p = *(const u32x4*)mp;
                        o0 += bf_lo(p.x); o1 += bf_hi(p.x); o2 += bf_lo(p.y); o3 += bf_hi(p.y); o4 += bf_lo(p.z); o5 += bf_hi(p.z); o6 += bf_lo(p.w); o7 += bf_hi(p.w); }
                    u32x4 w; w.x = cvt_pk_bf16(o0, o1); w.y = cvt_pk_bf16(o2, o3); w.z = cvt_pk_bf16(o4, o5); w.w = cvt_pk_bf16(o6, o7);
                    *(u32x4*)mp = w; } }
    }
};

struct EpiRes {
    static constexpr bool PERM = false, AFTER_DRAIN = false;
    const float* base; float* out; const float* gate;
    __device__ __forceinline__ void operator()(const f32x4 (&acc)[2][2][4][2], const Unit& u, int wr, int wc, int fr, int fq) const {
        const float* gp = gate + (size_t)(u.pm >> 3) * 6144;
        const int col0 = u.pn * BM + wc * 32 + 4 * fq;
#pragma unroll
        for (int bj = 0; bj < 2; ++bj)
#pragma unroll
            for (int n = 0; n < 2; ++n) { const int c = col0 + bj * HALF + n * 16; const f32x4 g4 = *(const f32x4*)(gp + c);
#pragma unroll
                for (int ai = 0; ai < 2; ++ai)
#pragma unroll
                    for (int m = 0; m < 4; ++m) { const size_t off = (size_t)(u.pm * BM + ai * HALF + wr * 64 + m * 16 + fr) * 1024 + c;
                        const f32x4 bs = *(const f32x4*)(base + off); *(f32x4*)(out + off) = bs + g4 * acc[ai][bj][m][n]; } }
    }
};

struct EpiPlain {
    static constexpr bool PERM = true, AFTER_DRAIN = false;
    bf16_t* O; int ldc;
    __device__ __forceinline__ void operator()(const f32x4 (&acc)[2][2][4][2], const Unit& u, int wr, int wc, int fr, int fq) const {
        const int row0 = u.pm * BM + wr * 64 + fr, col0 = u.pn * BM + wc * 32 + 8 * fq;
#pragma unroll
        for (int ai = 0; ai < 2; ++ai)
#pragma unroll
            for (int m = 0; m < 4; ++m) { bf16_t* rowp = O + (size_t)(row0 + ai * HALF + m * 16) * ldc + col0;
#pragma unroll
                for (int bj = 0; bj < 2; ++bj) { const f32x4 v0 = acc[ai][bj][m][0], v1 = acc[ai][bj][m][1];
                    u32x4 w; w.x = cvt_pk_bf16(v0[0], v0[1]); w.y = cvt_pk_bf16(v0[2], v0[3]); w.z = cvt_pk_bf16(v1[0], v1[1]); w.w = cvt_pk_bf16(v1[2], v1[3]);
                    *(u32x4*)(rowp + bj * HALF) = w; } }
    }
};
template <class Epi, class Sched, bool ALIGN_EPI = false, bool SP2 = false>
__device__ __forceinline__ void gemm_phase(PG8_LAS unsigned char* lds, const Gemm g, const Sched& S, const Epi& E) {
    int tid_l = threadIdx.x; asm volatile("" : "+v"(tid_l)); const int tid = tid_l, wid = __builtin_amdgcn_readfirstlane(tid >> 6), lane = tid & 63, wr = wid >> 2, wc = wid & 3, fr = lane & 15, fq = lane >> 4;
    const int K = g.K, nt = K / BK, lda = g.lda;
    unsigned voffA[2], voffB[2];
#pragma unroll
    for (int i = 0; i < 2; ++i) { int R, C; stage_rc(tid * 16 + i * 8192, R, C); const int Rb = Epi::PERM ? ((R & ~31) + perm32(R & 31)) : R;
        voffA[i] = (unsigned)(R * lda + C) * 2u; voffB[i] = (unsigned)(Rb * K + C) * 2u; }
    const size_t kstep = (size_t)(BK * 2);
    const size_t hstep = (size_t)HALF * K * 2;
    const size_t tstep = 2 * hstep; const size_t hstepA = (size_t)HALF * lda * 2, tstepA = 2 * hstepA;
    const unsigned ldsw = (unsigned)wid * 1024u;
    const int aoff = lds_byte(wr * 64 + fr, fq * 8), boff = lds_byte(wc * 32 + fr, fq * 8);
#define PG8_SA(b, h) (((b) * 2 + (h)) * HTB)
#define PG8_SB(b, h) ((4 + (b) * 2 + (h)) * HTB)
#define PG8_STAGE(bufoff, gbase, voff) do { _Pragma("unroll") for (int _i = 0; _i < 2; ++_i) \
        __builtin_amdgcn_global_load_lds((const unsigned*)((const char*)(gbase) + (voff)[_i]), (PG8_LAS unsigned*)(lds + (bufoff) + ldsw + _i * 8192), 16, 0, 0); } while (0)
#define PG8_LDA(dst, b, h) do { _Pragma("unroll") for (int m = 0; m < 4; ++m) _Pragma("unroll") for (int k = 0; k < 2; ++k) dst[m][k] = *(const PG8_LAS bf16x8*)(lds + PG8_SA(b, h) + aoff + m * 2048 + k * 1024); } while (0)
#define PG8_LDB(dst, b, h) do { _Pragma("unroll") for (int n = 0; n < 2; ++n) _Pragma("unroll") for (int k = 0; k < 2; ++k) dst[n][k] = *(const PG8_LAS bf16x8*)(lds + PG8_SB(b, h) + boff + n * 2048 + k * 1024); } while (0)
#define PG8_MMA(ai, bj, At, Bt) do { __builtin_amdgcn_s_setprio(1); _Pragma("unroll") for (int m = 0; m < 4; ++m) _Pragma("unroll") for (int n = 0; n < 2; ++n) _Pragma("unroll") for (int k = 0; k < 2; ++k) \
        acc[ai][bj][m][n] = __builtin_amdgcn_mfma_f32_16x16x32_bf16(Bt[n][k], At[m][k], acc[ai][bj][m][n], 0, 0, 0); __builtin_amdgcn_s_setprio(0); } while (0)
#define PG8_WAIT_V(n) asm volatile("s_waitcnt vmcnt(" #n ")" ::: "memory")
#define PG8_WAIT_L(n) asm volatile("s_waitcnt lgkmcnt(" #n ")" ::: "memory")
#define PG8_BAR __builtin_amdgcn_s_barrier()
#define PG8_SCHED __builtin_amdgcn_sched_barrier(0)
    Unit cur, nxt; int ui = 0;
    if (!S.next(0, cur)) return;
    f32x4 acc[2][2][4][2];
#pragma unroll
    for (int a = 0; a < 2; ++a)
#pragma unroll
        for (int b = 0; b < 2; ++b)
#pragma unroll
            for (int m = 0; m < 4; ++m)
#pragma unroll
                for (int n = 0; n < 2; ++n) acc[a][b][m][n] = (f32x4){0.f, 0.f, 0.f, 0.f};
    bf16x8 At[4][2], B0[2][2], B1[2][2];
    const char* cA = (const char*)g.A + (size_t)cur.pm * tstepA; const char* cB = (const char*)g.Bt + (size_t)cur.pn * tstep;
    S.a_ready(cur);
    if constexpr (SP2) {
        PG8_STAGE(PG8_SB(0, 0), cB, voffB); PG8_STAGE(PG8_SB(0, 1), cB + hstep, voffB); PG8_STAGE(PG8_SA(0, 0), cA, voffA); PG8_STAGE(PG8_SA(0, 1), cA + hstepA, voffA);
        if (wr == 1) PG8_BAR;
        PG8_WAIT_V(2); PG8_BAR;
        PG8_STAGE(PG8_SB(1, 0), cB + kstep, voffB); PG8_STAGE(PG8_SA(1, 0), cA + kstep, voffA); PG8_STAGE(PG8_SB(1, 1), cB + hstep + kstep, voffB);
        PG8_WAIT_V(6); PG8_BAR;
    } else {
        PG8_STAGE(PG8_SB(0, 0), cB, voffB); PG8_STAGE(PG8_SA(0, 0), cA, voffA); PG8_STAGE(PG8_SB(0, 1), cB + hstep, voffB); PG8_STAGE(PG8_SA(0, 1), cA + hstepA, voffA);
        if (wr == 1) PG8_BAR;
        PG8_WAIT_V(4); PG8_BAR;
        PG8_STAGE(PG8_SB(1, 0), cB + kstep, voffB); PG8_STAGE(PG8_SA(1, 0), cA + kstep, voffA); PG8_STAGE(PG8_SB(1, 1), cB + hstep + kstep, voffB);
        PG8_WAIT_V(6); PG8_BAR;
    }
    for (;;) {
        const bool has_next = S.next(ui + 1, nxt);
        const char* nA = has_next ? (const char*)g.A + (size_t)nxt.pm * tstepA : cA; const char* nB = has_next ? (const char*)g.Bt + (size_t)nxt.pn * tstep : cB;
        for (int t = 0; t < nt; t += 2) {
            const bool last = (t == nt - 2);
            const char* a1 = cA + (size_t)(t + 1) * kstep;
            const char* a2 = last ? nA : cA + (size_t)(t + 2) * kstep; const char* b2 = last ? nB : cB + (size_t)(t + 2) * kstep;
            const char* a3 = a2 + kstep; const char* b3 = b2 + kstep;
            if (last && has_next) S.a_ready(nxt);
            if constexpr (SP2) {
            PG8_LDB(B0, 0, 0); PG8_LDB(B1, 0, 1); PG8_SCHED; PG8_LDA(At, 0, 0); PG8_STAGE(PG8_SA(1, 1), a1 + hstepA, voffA);
            PG8_WAIT_V(8); PG8_WAIT_L(0); PG8_BAR; PG8_MMA(0, 0, At, B0); PG8_MMA(0, 1, At, B1); PG8_BAR; PG8_SCHED;
            PG8_LDA(At, 0, 1); PG8_STAGE(PG8_SB(0, 0), b2, voffB); PG8_STAGE(PG8_SB(0, 1), b2 + hstep, voffB); PG8_STAGE(PG8_SA(0, 0), a2, voffA);
            PG8_WAIT_V(8); PG8_WAIT_L(0); PG8_BAR; PG8_MMA(1, 0, At, B0); PG8_MMA(1, 1, At, B1); PG8_BAR; PG8_SCHED;
            PG8_LDB(B0, 1, 0); PG8_LDB(B1, 1, 1); PG8_SCHED; PG8_LDA(At, 1, 0); PG8_STAGE(PG8_SA(0, 1), a2 + hstepA, voffA);
            PG8_WAIT_V(8); PG8_WAIT_L(0); PG8_BAR; PG8_MMA(0, 0, At, B0); PG8_MMA(0, 1, At, B1); PG8_BAR; PG8_SCHED;
            PG8_LDA(At, 1, 1); PG8_STAGE(PG8_SB(1, 0), b3, voffB); PG8_STAGE(PG8_SB(1, 1), b3 + hstep, voffB); PG8_STAGE(PG8_SA(1, 0), a3, voffA);
            PG8_WAIT_V(8); PG8_WAIT_L(0); PG8_BAR; PG8_MMA(1, 0, At, B0); PG8_MMA(1, 1, At, B1); PG8_BAR; PG8_SCHED;
            } else {
            PG8_LDB(B0, 0, 0); PG8_SCHED; PG8_LDA(At, 0, 0); PG8_STAGE(PG8_SA(1, 1), a1 + hstepA, voffA);
            PG8_WAIT_L(8); PG8_BAR; PG8_WAIT_L(0); PG8_MMA(0, 0, At, B0); PG8_BAR; PG8_SCHED;
            PG8_LDB(B1, 0, 1); PG8_STAGE(PG8_SB(0, 0), b2, voffB);
            PG8_BAR; PG8_WAIT_L(0); PG8_MMA(0, 1, At, B1); PG8_BAR;
            PG8_LDA(At, 0, 1); PG8_STAGE(PG8_SA(0, 0), a2, voffA);
            PG8_BAR; PG8_WAIT_L(0); PG8_MMA(1, 0, At, B0); PG8_BAR; PG8_SCHED;
            PG8_STAGE(PG8_SB(0, 1), b2 + hstep, voffB);
            PG8_WAIT_V(6); PG8_BAR; PG8_MMA(1, 1, At, B1); PG8_BAR;
            PG8_LDB(B0, 1, 0); PG8_SCHED; PG8_LDA(At, 1, 0); PG8_STAGE(PG8_SA(0, 1), a2 + hstepA, voffA);
            PG8_WAIT_L(8); PG8_BAR; PG8_WAIT_L(0); PG8_MMA(0, 0, At, B0); PG8_BAR; PG8_SCHED;
            PG8_LDB(B1, 1, 1); PG8_STAGE(PG8_SB(1, 0), b3, voffB);
            PG8_BAR; PG8_WAIT_L(0); PG8_MMA(0, 1, At, B1); PG8_BAR;
            PG8_LDA(At, 1, 1); PG8_STAGE(PG8_SA(1, 0), a3, voffA);
            PG8_BAR; PG8_WAIT_L(0); PG8_MMA(1, 0, At, B0); PG8_BAR; PG8_SCHED;
            PG8_STAGE(PG8_SB(1, 1), b3 + hstep, voffB);
            PG8_WAIT_V(6); PG8_BAR; PG8_MMA(1, 1, At, B1); PG8_BAR;
            }
        }
        if constexpr (ALIGN_EPI) { if (wr == 0) PG8_BAR; }
        if constexpr (!Epi::AFTER_DRAIN) { E(acc, cur, wr, wc, fr, fq); S.done(cur); }
        if (!has_next) break;
#pragma unroll
        for (int a = 0; a < 2; ++a)
#pragma unroll
            for (int b = 0; b < 2; ++b)
#pragma unroll
                for (int m = 0; m < 4; ++m)
#pragma unroll
                    for (int n = 0; n < 2; ++n) acc[a][b][m][n] = (f32x4){0.f, 0.f, 0.f, 0.f};
        cur = nxt; cA = nA; cB = nB; ++ui;
        if constexpr (ALIGN_EPI) { if (wr == 1) PG8_BAR; }
    }
    PG8_WAIT_V(0);
    if constexpr (!ALIGN_EPI) { if (wr == 0) PG8_BAR; }
    PG8_BAR;
    if constexpr (Epi::AFTER_DRAIN) { E.fused(acc, cur, wr, wc, fr, fq, lds, wid, lane); S.done(cur); }
#undef PG8_SA
#undef PG8_SB
#undef PG8_STAGE
#undef PG8_LDA
#undef PG8_LDB
#undef PG8_MMA
#undef PG8_WAIT_V
#undef PG8_WAIT_L
#undef PG8_BAR
#undef PG8_SCHED
}
}

namespace attn_body {
using bf16=__hip_bfloat16;
using bf16x8=__attribute__((ext_vector_type(8)))short;
using s16x4=__attribute__((ext_vector_type(4)))short;
using f32x16=__attribute__((ext_vector_type(16)))float;
using u32x4=__attribute__((ext_vector_type(4)))unsigned;
using f32x4v=__attribute__((ext_vector_type(4)))float;
__device__ __forceinline__ float bf2f(short v){return __uint_as_float(((unsigned)(unsigned short)v)<<16);}
constexpr int BATCH=8,NHEAD=8,SEQ=2048,D=64,DM=4608;
constexpr int NW=8,QBLK=32,QB=QBLK*NW,KVBLK=64,NQB=SEQ/QB;
constexpr int ATTN_PITCH=DM, ATTN_UNIT_ROWS=QB;
__device__ __forceinline__ int crow(int r,int hi){return (r&3)+8*(r>>2)+4*hi;}
#define SBAR() __builtin_amdgcn_sched_barrier(0)
__device__ __forceinline__ void cmask(f32x16&p0,f32x16&p1,int jb,int qrel,int hi){
  const float NEG=-INFINITY; int kb=64*jb+4*hi;
  #pragma unroll
  for(int r=0;r<16;++r){int kv=kb+(r&3)+8*(r>>2); if(kv>qrel)p0[r]=NEG; if(kv+32>qrel)p1[r]=NEG;}
}

constexpr int NSLOT=3, SLOTB=8192;
constexpr int LDS_K=0, LDS_V=NSLOT*SLOTB, LDS_WS=2*NSLOT*SLOTB, LDS_OST=LDS_WS+NW*64*4, LDS_BYTES=LDS_OST+NW*4096;
constexpr float C2=0.125f*1.4426950408889634f;
__device__ __forceinline__ void glds16(const void*gsrc,unsigned lds_dst){unsigned keep;
  asm volatile("s_mov_b32 %0, m0\n\ts_mov_b32 m0, %2\n\ts_nop 0\n\tglobal_load_lds_dwordx4 %1, off\n\ts_mov_b32 m0, %0":"=&s"(keep):"v"(gsrc),"s"(lds_dst):"memory");}
__device__ __forceinline__ float max3f(float a,float b,float c){float r;asm("v_max3_f32 %0, %1, %2, %3":"=v"(r):"v"(a),"v"(b),"v"(c));return r;}
__device__ __forceinline__ float max2f(float a,float b){float r;asm("v_max_f32_e32 %0, %1, %2":"=v"(r):"v"(a),"v"(b));return r;}
__device__ __forceinline__ float fadd_s(float a,float b){float r;asm("v_add_f32_e32 %0, %1, %2":"=v"(r):"v"(a),"v"(b));return r;}
__device__ __forceinline__ float fsub_s(float a,float b){float r;asm("v_sub_f32_e32 %0, %1, %2":"=v"(r):"v"(a),"v"(b));return r;}
typedef float f32x2_t __attribute__((ext_vector_type(2))); typedef __bf16 bf16x2_t __attribute__((ext_vector_type(2)));
__device__ __forceinline__ unsigned cvtpk_s(float lo,float hi){f32x2_t v={lo,hi};bf16x2_t b=__builtin_convertvector(v,bf16x2_t);return __builtin_bit_cast(unsigned,b);}
#define WAIT_BAR(N) asm volatile("s_waitcnt vmcnt(" #N ") lgkmcnt(0)\n\ts_barrier":::"memory")

__device__ __forceinline__ void qkt(f32x16&p0,f32x16&p1,const char*Kslot,const bf16x8*qr,const f32x16&negm,int r32,int hi){
  const char*kb=Kslot+hi*1024+r32*16;
  #pragma unroll
  for(int d0=0;d0<4;++d0){
    const bf16x8 b0=*reinterpret_cast<const bf16x8*>(kb+d0*2048);
    const bf16x8 b1=*reinterpret_cast<const bf16x8*>(kb+d0*2048+512);
    if(d0==0){p0=__builtin_amdgcn_mfma_f32_32x32x16_bf16(b0,qr[0],negm,0,0,0);p1=__builtin_amdgcn_mfma_f32_32x32x16_bf16(b1,qr[0],negm,0,0,0);}
    else{p0=__builtin_amdgcn_mfma_f32_32x32x16_bf16(b0,qr[d0],p0,0,0,0);p1=__builtin_amdgcn_mfma_f32_32x32x16_bf16(b1,qr[d0],p1,0,0,0);}}
}
typedef __attribute__((address_space(3))) const char* lds_cptr;
typedef short v4i16_t __attribute__((ext_vector_type(4)));
__device__ __forceinline__ void kload8(bf16x8*kf,lds_cptr kp){
  kf[0]=*(const __attribute__((address_space(3))) bf16x8*)(kp);      kf[1]=*(const __attribute__((address_space(3))) bf16x8*)(kp+512);
  kf[2]=*(const __attribute__((address_space(3))) bf16x8*)(kp+2048); kf[3]=*(const __attribute__((address_space(3))) bf16x8*)(kp+2560);
  kf[4]=*(const __attribute__((address_space(3))) bf16x8*)(kp+4096); kf[5]=*(const __attribute__((address_space(3))) bf16x8*)(kp+4608);
  kf[6]=*(const __attribute__((address_space(3))) bf16x8*)(kp+6144); kf[7]=*(const __attribute__((address_space(3))) bf16x8*)(kp+6656);
}
__device__ __forceinline__ void kload2(bf16x8*kf,lds_cptr kp,int j){ kf[2*j]=*(const __attribute__((address_space(3))) bf16x8*)(kp+j*2048); kf[2*j+1]=*(const __attribute__((address_space(3))) bf16x8*)(kp+j*2048+512); }
__device__ __forceinline__ s16x4 vtr(lds_cptr p){ return __builtin_bit_cast(s16x4,__builtin_amdgcn_ds_read_tr16_b64_v4i16((__attribute__((address_space(3))) v4i16_t*)p)); }
__device__ __forceinline__ float rowmax(const f32x16&p0,const f32x16&p1){
  float a=max3f(p0[0],p0[1],p1[0]),b=max3f(p0[2],p0[3],p1[1]);a=max3f(a,p1[2],p1[3]);
  #pragma unroll
  for(int r=4;r<16;r+=4){a=max3f(a,p0[r],p0[r+1]);b=max3f(b,p0[r+2],p0[r+3]);a=max3f(a,p1[r],p1[r+1]);b=max3f(b,p1[r+2],p1[r+3]);}
  const float m=max2f(a,b);
  auto rr=__builtin_amdgcn_permlane32_swap(__float_as_uint(m),__float_as_uint(m),false,false);
  return max2f(__uint_as_float(rr[0]),__uint_as_float(rr[1]));
}
__device__ __forceinline__ void pv(f32x16*o,int vb,bf16x8 pa0,bf16x8 pa1,bf16x8 pa2,bf16x8 pa3){
  #pragma unroll
  for(int d0=0;d0<2;++d0){s16x4 lo[4],hi[4];
    #pragma unroll
    for(int ks=0;ks<4;++ks){
      asm volatile("ds_read_b64_tr_b16 %0,%1 offset:%c2":"=&v"(lo[ks]):"v"(vb),"i"(d0*4096+ks*1024):"memory");
      asm volatile("ds_read_b64_tr_b16 %0,%1 offset:%c2":"=&v"(hi[ks]):"v"(vb),"i"(d0*4096+ks*1024+512):"memory");}
    asm volatile("s_waitcnt lgkmcnt(0)":::"memory");SBAR();
    #define PK(k) (bf16x8){lo[k][0],lo[k][1],lo[k][2],lo[k][3],hi[k][0],hi[k][1],hi[k][2],hi[k][3]}
    o[d0]=__builtin_amdgcn_mfma_f32_32x32x16_bf16(pa0,PK(0),o[d0],0,0,0);
    o[d0]=__builtin_amdgcn_mfma_f32_32x32x16_bf16(pa1,PK(1),o[d0],0,0,0);
    o[d0]=__builtin_amdgcn_mfma_f32_32x32x16_bf16(pa2,PK(2),o[d0],0,0,0);
    o[d0]=__builtin_amdgcn_mfma_f32_32x32x16_bf16(pa3,PK(3),o[d0],0,0,0);
    #undef PK
  }
}

#ifndef ATTN_STORE16
#define ATTN_STORE16(p,v) (*(u32x4*)(p)=(v))
#endif
template<int THRL> __device__ __forceinline__ void attn_unit(int b,int h,int qb,const bf16*Q,const bf16*__restrict__ K,const bf16*__restrict__ V,bf16*O,const float*km,char*shm){
  int tid_l=threadIdx.x; asm volatile("":"+v"(tid_l)); const int tid=tid_l,lane=tid&63,r32=lane&31,hi=lane>>5; const int wid=__builtin_amdgcn_readfirstlane(tid>>6);
  const long rowbase=(long)b*SEQ; const int q0=qb*QB;
  const bf16*Qw=Q+(rowbase+q0+wid*QBLK)*DM+h*D;
  const bf16*Kh=K+rowbase*DM+h*D,*Vh=V+rowbase*DM+h*D;
  const unsigned lds0=(unsigned)(uintptr_t)shm;
  float*wsf=(float*)(shm+LDS_WS)+wid*64;
  const bf16*ksrc=Kh+(long)lane*DM+wid*8;
  const bf16*vsrc=Vh+(long)(16*(wid&3)+(lane>>2))*DM+(wid>>2)*32+(lane&3)*8;
  const unsigned kdst=lds0+LDS_K+wid*1024, vdst=lds0+LDS_V+wid*1024;
  #define DMA_K(t,slot) glds16(ksrc+(long)(t)*KVBLK*DM,(unsigned)__builtin_amdgcn_readfirstlane(kdst+(slot)))
  #define DMA_V(t,slot) glds16(vsrc+(long)(t)*KVBLK*DM,(unsigned)__builtin_amdgcn_readfirstlane(vdst+(slot)))
  const int vb0=(int)(lds0+LDS_V)+((lane>>4)&1)*32+(lane&3)*8+(4*hi+((lane&15)>>2))*64;
  const char*Kbase=shm+LDS_K; bf16x8 kf[8];
  const lds_cptr shm3=(lds_cptr)shm; const lds_cptr kp0=shm3+LDS_K+hi*1024+r32*16; const lds_cptr vp0=shm3+LDS_V+((lane>>4)&1)*32+(lane&3)*8+(4*hi+((lane&15)>>2))*64;
  const int NT=(q0+QB)/KVBLK;
  DMA_K(0,0);DMA_V(0,0);DMA_K(1,SLOTB);
  bf16x8 qr[4];
  #pragma unroll
  for(int d0=0;d0<4;++d0)qr[d0]=*reinterpret_cast<const bf16x8*>(&Qw[(long)r32*DM+d0*16+hi*8]);

  unsigned sel=(1u<<qb)-1u;
  if(qb>3){
    float rt[7];
    #pragma unroll
    for(int j=0;j<7;++j){ float pr=-INFINITY;
      if(j<qb){ const float*kp=km+j*64+8*hi; float s=0.f;
        #pragma unroll
        for(int d0=0;d0<4;++d0){ const f32x4v ka=*(const f32x4v*)(kp+16*d0)+*(const f32x4v*)(kp+32768+16*d0), kb2=*(const f32x4v*)(kp+16*d0+4)+*(const f32x4v*)(kp+32768+16*d0+4);
          s+=bf2f(qr[d0][0])*ka[0]+bf2f(qr[d0][1])*ka[1]+bf2f(qr[d0][2])*ka[2]+bf2f(qr[d0][3])*ka[3]+bf2f(qr[d0][4])*kb2[0]+bf2f(qr[d0][5])*kb2[1]+bf2f(qr[d0][6])*kb2[2]+bf2f(qr[d0][7])*kb2[3]; }
        s+=__shfl_xor(s,32); pr=s; }
      rt[j]=pr; }
    sel=0u;
    #pragma unroll
    for(int j=0;j<7;++j){ int rank=0;
      #pragma unroll
      for(int i=0;i<7;++i){ if(i!=j) rank+=((rt[i]>rt[j])||((rt[i]==rt[j])&&(i<j)))?1:0; }
      if(j<qb&&rank<3) sel|=(1u<<j); }
  }
  const float NEGB=-16384.f;
  float mhat=0.f,l_reg=0.f;f32x16 o[2];o[0]=f32x16{};o[1]=f32x16{};f32x16 negm=f32x16{};asm volatile("":"+v"(negm));
  const int qrel=wid*QBLK+r32;
  #define CMASK(P0,P1,t) do{int jb_=(t)-(NT-4); if(jb_>=0)cmask(P0,P1,jb_,qrel,hi); else if(!((sel>>((t)>>2))&1u)){ _Pragma("unroll") for(int r_=0;r_<16;++r_){P0[r_]=NEGB;P1[r_]=NEGB;} } }while(0)
  bool resc=false;
  #define START(P0,P1) do{ const float rm=rowmax(P0,P1); resc=false; \
    { const float dl=rm; mhat=fadd_s(mhat,dl); \
      _Pragma("unroll") for(int r=0;r<16;++r){P0[r]=fsub_s(P0[r],dl);P1[r]=fsub_s(P1[r],dl);} \
      _Pragma("unroll") for(int r=0;r<16;++r)negm[r]=-mhat; asm volatile("":"+v"(negm)); } \
    _Pragma("unroll") for(int r=0;r<16;++r)P0[r]=__builtin_amdgcn_exp2f(P0[r]); }while(0)
  #define RESC() do{ if(resc){ asm volatile("s_waitcnt lgkmcnt(0)":::"memory"); \
      _Pragma("unroll") for(int d_=0;d_<2;++d_) _Pragma("unroll") for(int r=0;r<16;++r)o[d_][r]*=wsf[crow(r,hi)]; } }while(0)
  f32x16 pA0,pA1,pB0,pB1;
  int sl_prev=0,sl_cur=0,sl_next=SLOTB;
  #define ROT() do{sl_prev=sl_cur;sl_cur=sl_next;sl_next=(sl_next==(NSLOT-1)*SLOTB)?0:sl_next+SLOTB;}while(0)
  DMA_K(2,2*SLOTB);
  WAIT_BAR(3);
  qkt(pA0,pA1,Kbase,qr,negm,r32,hi);asm volatile("s_nop 15\n\ts_nop 7":"+v"(pA0),"+v"(pA1));CMASK(pA0,pA1,0);
  START(pA0,pA1);
  _Pragma("unroll") for(int r=0;r<16;++r)pA1[r]=__builtin_amdgcn_exp2f(pA1[r]);
  WAIT_BAR(0);
  DMA_K(3,0);DMA_V(1,SLOTB);
  ROT();
  kload8(kf,kp0+sl_cur);
  WAIT_BAR(2);
  s16x4 vlo[8],vhi[8]; u32x4 pw0,pw1,pw2,pw3;
  #define PKW(P,B) cvtpk_s(P[B],P[B+1])
  #define PAF(k) __builtin_bit_cast(bf16x8,pw##k)
  #define VFR(i) (bf16x8){vlo[i][0],vlo[i][1],vlo[i][2],vlo[i][3],vhi[i][0],vhi[i][1],vhi[i][2],vhi[i][3]}
  #define PIN(x) asm volatile("":"+v"(x))
  #define MX3(a,b,c) __builtin_fmaxf(__builtin_fmaxf((a),(b)),(c))
  #define GAPA(MF,A0,A1,A2,A3,W0,W1,PW) do{ MF; sacc+=A0; sacc+=A1; sacc+=A2; sacc+=A3; PIN(sacc); W0; W1; PIN(PW); SBAR(); }while(0)
  #define EX(v) __builtin_amdgcn_exp2f(v)
  #define GAPB(MF,X,B) do{ MF; X[B]=EX(X[B]); X[B+1]=EX(X[B+1]); X[B+2]=EX(X[B+2]); X[B+3]=EX(X[B+3]); PIN(X); SBAR(); }while(0)
  #define VRD(i) do{ vlo[i]=vtr(vp_+(((i)>>2)*4096+((i)&3)*1024)); vhi[i]=vtr(vp_+(((i)>>2)*4096+((i)&3)*1024+512)); }while(0)
  #define KRD(G,j) do{ if(G){ kload2(kf,kp0+sl_next,j); SBAR(); } }while(0)
  #define STEP(C0,C1,P0,P1,t,GK,GV,GL) do{ SBAR(); \
    const lds_cptr vp_=vp0+sl_prev; \
    VRD(0); SBAR(); float sacc=(P0[0]+P0[1]); \
    GAPA(C0=__builtin_amdgcn_mfma_f32_32x32x16_bf16(kf[0],qr[0],negm,0,0,0), P0[2],P0[3],P0[4],P0[5],     pw0[0]=PKW(P0,0), pw0[1]=PKW(P0,2), pw0); \
    VRD(4); SBAR(); GAPA(C1=__builtin_amdgcn_mfma_f32_32x32x16_bf16(kf[1],qr[0],negm,0,0,0), P0[6],P0[7],P0[8],P0[9],     pw0[2]=PKW(P0,4), pw0[3]=PKW(P0,6), pw0); \
    VRD(1); SBAR(); GAPA(C0=__builtin_amdgcn_mfma_f32_32x32x16_bf16(kf[2],qr[1],C0,0,0,0),   P0[10],P0[11],P0[12],P0[13], pw1[0]=PKW(P0,8), pw1[1]=PKW(P0,10), pw1); \
    VRD(5); SBAR(); GAPA(C1=__builtin_amdgcn_mfma_f32_32x32x16_bf16(kf[3],qr[1],C1,0,0,0),   P0[14],P0[15],P1[0],P1[1],   pw1[2]=PKW(P0,12),pw1[3]=PKW(P0,14), pw1); \
    VRD(2); SBAR(); GAPA(C0=__builtin_amdgcn_mfma_f32_32x32x16_bf16(kf[4],qr[2],C0,0,0,0),   P1[2],P1[3],P1[4],P1[5],     pw2[0]=PKW(P1,0), pw2[1]=PKW(P1,2), pw2); \
    VRD(6); SBAR(); GAPA(C1=__builtin_amdgcn_mfma_f32_32x32x16_bf16(kf[5],qr[2],C1,0,0,0),   P1[6],P1[7],P1[8],P1[9],     pw2[2]=PKW(P1,4), pw2[3]=PKW(P1,6), pw2); \
    VRD(3); SBAR(); GAPA(C0=__builtin_amdgcn_mfma_f32_32x32x16_bf16(kf[6],qr[3],C0,0,0,0),   P1[10],P1[11],P1[12],P1[13], pw3[0]=PKW(P1,8), pw3[1]=PKW(P1,10), pw3); \
    VRD(7); SBAR(); GAPA(C1=__builtin_amdgcn_mfma_f32_32x32x16_bf16(kf[7],qr[3],C1,0,0,0),   P1[14],P1[15],0.f,0.f,       pw3[2]=PKW(P1,12),pw3[3]=PKW(P1,14), pw3); \
    l_reg+=sacc; \
    if(GK){DMA_K((t)+3,sl_cur);} if(GV){DMA_V((t)+1,sl_next);} \
    CMASK(C0,C1,t); \
    { float a=MX3(C0[0],C0[1],C1[0]),b=MX3(C0[2],C0[3],C1[1]); a=MX3(a,C1[2],C1[3]); \
      _Pragma("unroll") for(int r=4;r<16;r+=4){a=MX3(a,C0[r],C0[r+1]);b=MX3(b,C0[r+2],C0[r+3]);a=MX3(a,C1[r],C1[r+1]);b=MX3(b,C1[r+2],C1[r+3]);} \
      float rm=__builtin_fmaxf(a,b); { auto rr=__builtin_amdgcn_permlane32_swap(__float_as_uint(rm),__float_as_uint(rm),false,false); rm=__builtin_fmaxf(__uint_as_float(rr[0]),__uint_as_float(rr[1])); } \
      resc=false; \
      if(__builtin_expect(__any(rm>(float)THRL),0)){ const float dl=__builtin_fmaxf(rm,0.f); mhat+=dl; \
        _Pragma("unroll") for(int r=0;r<16;++r){C0[r]-=dl;C1[r]-=dl;} \
        _Pragma("unroll") for(int r=0;r<16;++r)negm[r]=-mhat; asm volatile("":"+v"(negm)); \
        const float f=__builtin_amdgcn_exp2f(-dl); l_reg*=f; if(hi==0)wsf[r32]=f; resc=true; } } \
    SBAR(); \
    GAPB(o[0]=__builtin_amdgcn_mfma_f32_32x32x16_bf16(PAF(0),VFR(0),o[0],0,0,0), C0,0); \
    GAPB(o[1]=__builtin_amdgcn_mfma_f32_32x32x16_bf16(PAF(0),VFR(4),o[1],0,0,0), C0,4); \
    KRD(GL,0); GAPB(o[0]=__builtin_amdgcn_mfma_f32_32x32x16_bf16(PAF(1),VFR(1),o[0],0,0,0), C0,8); \
    KRD(GL,1); GAPB(o[1]=__builtin_amdgcn_mfma_f32_32x32x16_bf16(PAF(1),VFR(5),o[1],0,0,0), C0,12); \
    KRD(GL,2); GAPB(o[0]=__builtin_amdgcn_mfma_f32_32x32x16_bf16(PAF(2),VFR(2),o[0],0,0,0), C1,0); \
    KRD(GL,3); GAPB(o[1]=__builtin_amdgcn_mfma_f32_32x32x16_bf16(PAF(2),VFR(6),o[1],0,0,0), C1,4); \
    GAPB(o[0]=__builtin_amdgcn_mfma_f32_32x32x16_bf16(PAF(3),VFR(3),o[0],0,0,0), C1,8); \
    GAPB(o[1]=__builtin_amdgcn_mfma_f32_32x32x16_bf16(PAF(3),VFR(7),o[1],0,0,0), C1,12); \
    }while(0)
  int t=1;
  for(;t+5<NT;t+=2){
    STEP(pB0,pB1,pA0,pA1,t,true,true,true);     WAIT_BAR(2); RESC(); ROT();
    STEP(pA0,pA1,pB0,pB1,t+1,true,true,true);   WAIT_BAR(2); RESC(); ROT();
  }
  #define ENDW(tt) do{ if((tt)+3<NT){WAIT_BAR(2);} else if((tt)+2<NT){WAIT_BAR(1);} else {WAIT_BAR(0);} }while(0)
  for(;t+1<NT;t+=2){
    STEP(pB0,pB1,pA0,pA1,t,(t+3<NT),(t+1<NT),(t+1<NT));       ENDW(t);   RESC(); ROT();
    STEP(pA0,pA1,pB0,pB1,t+1,(t+4<NT),(t+2<NT),(t+2<NT));     ENDW(t+1); RESC(); ROT();
  }
  STEP(pB0,pB1,pA0,pA1,NT-1,false,false,false); RESC();
  { float sacc=pB0[0]+pB0[1]; _Pragma("unroll") for(int r=2;r<16;++r)sacc+=pB0[r]; _Pragma("unroll") for(int r=0;r<16;++r)sacc+=pB1[r]; l_reg+=sacc;
    pw0=(u32x4){PKW(pB0,0),PKW(pB0,2),PKW(pB0,4),PKW(pB0,6)};pw1=(u32x4){PKW(pB0,8),PKW(pB0,10),PKW(pB0,12),PKW(pB0,14)};pw2=(u32x4){PKW(pB1,0),PKW(pB1,2),PKW(pB1,4),PKW(pB1,6)};pw3=(u32x4){PKW(pB1,8),PKW(pB1,10),PKW(pB1,12),PKW(pB1,14)};
    SBAR(); pv(o,vb0+sl_cur,PAF(0),PAF(1),PAF(2),PAF(3)); }
  #undef PKW
  #undef PAF
  #undef VFR
  #undef PIN
  #undef MX3
  #undef GAPA
  #undef GAPB
  #undef EX
  #undef VRD
  #undef KRD
  #undef STEP
  #undef ENDW
  {auto rr=__builtin_amdgcn_permlane32_swap(__float_as_uint(l_reg),__float_as_uint(l_reg),false,false);l_reg=__uint_as_float(rr[0])+__uint_as_float(rr[1]);}
  if(hi==0)wsf[32+r32]=l_reg;asm volatile("s_waitcnt lgkmcnt(0)":::"memory");
  float rli[16];
  #pragma unroll
  for(int r=0;r<16;++r)rli[r]=__builtin_amdgcn_rcpf(wsf[32+crow(r,hi)]);
  bf16*Ow=O+(rowbase+q0+wid*QBLK)*DM+h*D;
  { bf16*stg=(bf16*)(shm+LDS_OST)+wid*2048;
    #pragma unroll
    for(int r=0;r<16;++r){const int orow=crow(r,hi);
      #pragma unroll
      for(int d0=0;d0<2;++d0)stg[orow*64+d0*32+r32]=__float2bfloat16(o[d0][r]*rli[r]);}
    asm volatile("s_waitcnt lgkmcnt(0)":::"memory");
    #pragma unroll
    for(int i=0;i<4;++i){const int row=i*8+(lane>>3),ch=lane&7; const u32x4 v=*(const u32x4*)(stg+row*64+ch*8); ATTN_STORE16(Ow+(long)row*DM+ch*8,v);} }
  asm volatile("s_waitcnt lgkmcnt(0)\n\ts_barrier":::"memory");
  #undef DMA_K
  #undef DMA_V
  #undef CMASK
  #undef START
  #undef RESC
  #undef ROT
}
constexpr int ATTN_LDS_BYTES=LDS_BYTES;
#undef SBAR
#undef WAIT_BAR
}

#define GAS __attribute__((address_space(1)))
#define LAS __attribute__((address_space(3)))
typedef unsigned short bf16;
typedef unsigned v4u __attribute__((ext_vector_type(4)));
typedef unsigned v2u __attribute__((ext_vector_type(2)));
typedef float f32x4 __attribute__((ext_vector_type(4)));
typedef short bf16x8 __attribute__((ext_vector_type(8)));
#define LDS_WAIT() asm volatile("s_waitcnt lgkmcnt(0)" ::: "memory")
__device__ __forceinline__ unsigned f2bf(float f) { unsigned u = __builtin_bit_cast(unsigned, f); return (u + 0x7fffu + ((u >> 16) & 1u)) >> 16; }
__device__ __forceinline__ unsigned pk2(float lo, float hi) { return f2bf(lo) | (f2bf(hi) << 16); }

#ifndef PROBE
#define PROBE 0
#endif
constexpr int NWAVES = 8;
constexpr int DMODEL = 1024, NBATCH = 8, SEQL = 2048, MROWS = NBATCH * SEQL, NLAYER = 4;
constexpr int INW = 4608, DFF = 2816, UPW = 2 * DFF, NMODW = 6 * DMODEL;
constexpr int COL_Q = 0, COL_K = 512, COL_V = 1024, COL_U = 1536, COL_VS = 2048, COL_GA = 2560, COL_GS = 3584;
constexpr float RMS_EPS = 1e-6f;

constexpr size_t MiB = 1u << 20;
constexpr size_t WS_MOD = 0, WS_BAR = 896 * 1024, WS_BAR_BYTES = 16384, WS_KMS = 1 * MiB;
constexpr size_t WS_WIN = 2 * MiB;
constexpr size_t WS_WA = 11 * MiB;
constexpr size_t WS_WS = 12 * MiB;
constexpr size_t WS_WO = 13 * MiB;
constexpr size_t WS_WUP = 15 * MiB;
constexpr size_t WS_WDN = 26 * MiB;
constexpr size_t WS_WSG = 31 * MiB + 512 * 1024;
constexpr size_t WS_R1 = 32 * MiB;
constexpr size_t WS_G = 208 * MiB;
constexpr size_t WS_H = WS_G, WS_MG = WS_G + 32 * MiB;
constexpr size_t WS_END = 296 * MiB;

constexpr int RING_BYTES = 131072;
constexpr int LDS_BYTES = 147456;
constexpr int LDS_MISC = RING_BYTES;

__device__ __forceinline__ float wave_sum(float v) {
#pragma unroll
    for (int o = 1; o < 64; o <<= 1) v += __shfl_xor(v, o);
    return v;
}

__device__ __forceinline__ void transpose_item(const float* W, int K, int N, bf16* WT, LAS float* scr, int item, int lane) {
    const int nblk = N / 32, kb = item / nblk, nb = item % nblk, k0 = 64 * kb, n0 = 32 * nb;
#pragma unroll 8
    for (int i = 0; i < 32; ++i) { const int kk = 2 * i + (lane >> 5); scr[kk * 33 + (lane & 31)] = W[(size_t)(k0 + kk) * N + n0 + (lane & 31)]; }
    LDS_WAIT(); asm volatile("" ::: "memory");
    const int c = lane & 7;
#pragma unroll
    for (int j = 0; j < 4; ++j) { const int n = (lane >> 3) + 8 * j; const LAS float* s = scr + (8 * c) * 33 + n;
        v4u o; o.x = pk2(s[0 * 33], s[1 * 33]); o.y = pk2(s[2 * 33], s[3 * 33]); o.z = pk2(s[4 * 33], s[5 * 33]); o.w = pk2(s[6 * 33], s[7 * 33]);
        *(v4u*)(WT + (size_t)(n0 + n) * K + k0 + 8 * c) = o; }
    LDS_WAIT(); asm volatile("" ::: "memory");
}

__device__ __forceinline__ void norm_mod_row(const float* xrow, const float* g, const float* sc, const float* sh, bf16* orow, int lane) {
    f32x4 v[4]; float s = 0.f;
#pragma unroll
    for (int j = 0; j < 4; ++j) { v[j] = *(const f32x4*)(xrow + 4 * lane + 256 * j); s += (v[j].x * v[j].x + v[j].y * v[j].y) + (v[j].z * v[j].z + v[j].w * v[j].w); }
    const float rstd = 1.0f / sqrtf(wave_sum(s) * (1.0f / DMODEL) + RMS_EPS);
#pragma unroll
    for (int j = 0; j < 4; ++j) { const int c = 4 * lane + 256 * j;
        const f32x4 g4 = *(const f32x4*)(g + c), s4 = *(const f32x4*)(sc + c), h4 = *(const f32x4*)(sh + c);
        const f32x4 y = (v[j] * rstd * g4) * (s4 + 1.0f) + h4;
        v2u o; o.x = pk2(y.x, y.y); o.y = pk2(y.z, y.w); *(v2u*)(orow + c) = o; }
}
__device__ __forceinline__ void norm_final_row(const float* xrow, const float* g, float* orow, int lane) {
    f32x4 v[4]; float s = 0.f;
#pragma unroll
    for (int j = 0; j < 4; ++j) { v[j] = *(const f32x4*)(xrow + 4 * lane + 256 * j); s += (v[j].x * v[j].x + v[j].y * v[j].y) + (v[j].z * v[j].z + v[j].w * v[j].w); }
    const float rstd = 1.0f / sqrtf(wave_sum(s) * (1.0f / DMODEL) + RMS_EPS);
#pragma unroll
    for (int j = 0; j < 4; ++j) { const int c = 4 * lane + 256 * j; const f32x4 g4 = *(const f32x4*)(g + c); *(f32x4*)(orow + c) = v[j] * rstd * g4; }
}

__device__ __forceinline__ void phase_mod(const float* c, const float* w_mod, float* modp, LAS float* cact, int tid, int lane, int gw, int NGW) {
    for (int i = tid; i < NBATCH * DMODEL; i += NWAVES * 64) { const float v = c[i]; cact[i] = v / (1.0f + __expf(-v)); }
    __syncthreads();
    for (int it = gw; it < 96 * 16; it += NGW) {
        const int cgp = it % 96, kc = it / 96, l = cgp / 24, n0 = (cgp % 24) * 256 + 4 * lane;
        const float* wp = w_mod + ((size_t)l * DMODEL + kc * 64) * NMODW + n0;
        f32x4 acc[8];
#pragma unroll
        for (int b = 0; b < 8; ++b) acc[b] = (f32x4){0.f, 0.f, 0.f, 0.f};
#pragma unroll 8
        for (int k = 0; k < 64; ++k) { const f32x4 w = *(const f32x4*)(wp + (size_t)k * NMODW);
#pragma unroll
            for (int b = 0; b < 8; ++b) acc[b] += w * cact[b * DMODEL + kc * 64 + k]; }
#pragma unroll
        for (int b = 0; b < 8; ++b) *(f32x4*)(modp + ((size_t)(kc * 32 + l * 8 + b)) * NMODW + n0) = acc[b];
    }
}

__device__ __forceinline__ void phase_mod_reduce(const float* modp, const float* b_mod, float* mod, int gtid, int NGT) {
    for (int i4 = gtid; i4 < NLAYER * 8 * NMODW / 4; i4 += NGT) { const int i = i4 * 4, lb = i / NMODW, n = i % NMODW, l = lb >> 3;
        f32x4 s = *(const f32x4*)(b_mod + (size_t)l * NMODW + n);
#pragma unroll
        for (int kc = 0; kc < 16; ++kc) s += *(const f32x4*)(modp + ((size_t)(kc * 32 + lb)) * NMODW + n);
        *(f32x4*)(mod + i) = s; }
}

__device__ __forceinline__ void sgu_unit(int unit, bf16* P, const float* g_sgu, const bf16* Wsm, const float* b_s, LAS unsigned char* lds, int tid, int lane, int wave) {
    const int ihalf = unit & 1, bc = unit >> 1;
    const size_t row0 = (size_t)bc * 128;
    const int jmax = ihalf ? 128 : 64;
    LAS float* rstd = (LAS float*)(lds + LDS_MISC);
    for (int tt = 0; tt < 16; ++tt) { const int tok = wave * 16 + tt;
        const v4u w = *(const v4u*)(P + (row0 + tok) * INW + COL_VS + 8 * lane);
        float s = 0.f;
#pragma unroll
        for (int i = 0; i < 4; ++i) { const float a = pg8::bf_lo(w[i]), b2 = pg8::bf_hi(w[i]); s += a * a + b2 * b2; }
        s = wave_sum(s);
        if (lane == 0) rstd[tok] = 1.0f / sqrtf(s * (1.0f / 512.0f) + RMS_EPS);
    }
    __syncthreads();
    const int g = wave;
    LAS unsigned char* vt = lds + g * 16384;
    { const int c0 = (lane & 7) * 8; float gs[8];
#pragma unroll
        for (int e = 0; e < 8; ++e) gs[e] = g_sgu[g * 64 + c0 + e];
        for (int it = 0; it < jmax / 8; ++it) { const int j = it * 8 + (lane >> 3);
            const v4u w = *(const v4u*)(P + (row0 + j) * INW + COL_VS + g * 64 + c0);
            const float r = rstd[j];
#pragma unroll
            for (int e = 0; e < 8; ++e) { const float x = (e & 1) ? pg8::bf_hi(w[e >> 1]) : pg8::bf_lo(w[e >> 1]); const int c = c0 + e;
                *(LAS unsigned short*)(vt + c * 256 + ((((j >> 3) ^ (c & 15)) << 4) | ((j & 7) * 2))) = (unsigned short)f2bf(x * r * gs[e]); }
        }
    }
    LDS_WAIT(); asm volatile("" ::: "memory");
    f32x4 acc[4][4];
#pragma unroll
    for (int a = 0; a < 4; ++a)
#pragma unroll
        for (int b = 0; b < 4; ++b) acc[a][b] = (f32x4){0.f, 0.f, 0.f, 0.f};
    const int l15 = lane & 15, kq = lane >> 4;
    const bf16* Wg = Wsm + (size_t)g * 128 * 128;
    for (int ks = 0; ks < jmax / 32; ++ks) {
        bf16x8 af[4];
#pragma unroll
        for (int ct = 0; ct < 4; ++ct) { const int c = ct * 16 + l15; af[ct] = *(const LAS bf16x8*)(vt + c * 256 + (((ks * 4 + kq) ^ (c & 15)) << 4)); }
#pragma unroll
        for (int it = 0; it < 4; ++it) { const int itg = ihalf * 4 + it;
            if (32 * ks <= 16 * itg + 15) {
                const bf16x8 bfr = *(const bf16x8*)(Wg + (size_t)(itg * 16 + l15) * 128 + ks * 32 + 8 * kq);
#pragma unroll
                for (int ct = 0; ct < 4; ++ct) acc[it][ct] = __builtin_amdgcn_mfma_f32_16x16x32_bf16(af[ct], bfr, acc[it][ct], 0, 0, 0);
            } }
    }
#pragma unroll
    for (int it = 0; it < 4; ++it) { const int i = (ihalf * 4 + it) * 16 + l15; const float bias = b_s[g * 128 + i];
#pragma unroll
        for (int ct = 0; ct < 4; ++ct) { bf16* up = P + (row0 + i) * INW + COL_U + g * 64 + ct * 16 + 4 * kq;
            const v2u uw = *(const v2u*)up; const f32x4 d = acc[it][ct];
            v2u o; o.x = pk2(pg8::bf_lo(uw.x) * (d[0] + bias), pg8::bf_hi(uw.x) * (d[1] + bias)); o.y = pk2(pg8::bf_lo(uw.y) * (d[2] + bias), pg8::bf_hi(uw.y) * (d[3] + bias));
            *(v2u*)up = o; } }
    __syncthreads();
}

__device__ __forceinline__ void phase_conv(const bf16* U, const float* w_conv, const float* b_conv, bf16* Gb, int gtid, int NGT) {
    for (int idx = gtid; idx < (MROWS / 16) * (DFF / 8); idx += NGT) {
        const int rc = idx / (DFF / 8), cc = idx % (DFF / 8), c0 = cc * 8, t0 = rc * 16;
        float w0[16], w1[16], w2[16], bb[16], p1[16], p2[16];
#pragma unroll
        for (int hsel = 0; hsel < 2; ++hsel)
#pragma unroll
            for (int q = 0; q < 2; ++q) { const int col = hsel * DFF + c0 + 4 * q;
                const f32x4 a = *(const f32x4*)(w_conv + col), b = *(const f32x4*)(w_conv + UPW + col), c = *(const f32x4*)(w_conv + 2 * UPW + col), d = *(const f32x4*)(b_conv + col);
#pragma unroll
                for (int i = 0; i < 4; ++i) { w0[hsel * 8 + q * 4 + i] = a[i]; w1[hsel * 8 + q * 4 + i] = b[i]; w2[hsel * 8 + q * 4 + i] = c[i]; bb[hsel * 8 + q * 4 + i] = d[i]; } }
        const bool first = (t0 & (SEQL - 1)) == 0;
#pragma unroll
        for (int hsel = 0; hsel < 2; ++hsel) {
            v4u a = (v4u){0u, 0u, 0u, 0u}, b = (v4u){0u, 0u, 0u, 0u};
            if (!first) { a = *(const v4u*)(U + (size_t)(t0 - 2) * UPW + hsel * DFF + c0); b = *(const v4u*)(U + (size_t)(t0 - 1) * UPW + hsel * DFF + c0); }
#pragma unroll
            for (int i = 0; i < 4; ++i) { p2[hsel * 8 + 2 * i] = pg8::bf_lo(a[i]); p2[hsel * 8 + 2 * i + 1] = pg8::bf_hi(a[i]); p1[hsel * 8 + 2 * i] = pg8::bf_lo(b[i]); p1[hsel * 8 + 2 * i + 1] = pg8::bf_hi(b[i]); }
        }
#pragma unroll 2
        for (int t = 0; t < 16; ++t) {
            const v4u ua = *(const v4u*)(U + (size_t)(t0 + t) * UPW + c0), ul = *(const v4u*)(U + (size_t)(t0 + t) * UPW + DFF + c0);
            float cur[16], o[8];
#pragma unroll
            for (int i = 0; i < 4; ++i) { cur[2 * i] = pg8::bf_lo(ua[i]); cur[2 * i + 1] = pg8::bf_hi(ua[i]); cur[8 + 2 * i] = pg8::bf_lo(ul[i]); cur[8 + 2 * i + 1] = pg8::bf_hi(ul[i]); }
#pragma unroll
            for (int i = 0; i < 8; ++i) {
                const float a = bb[i] + w2[i] * cur[i] + w1[i] * p1[i] + w0[i] * p2[i];
                const float li = bb[8 + i] + w2[8 + i] * cur[8 + i] + w1[8 + i] * p1[8 + i] + w0[8 + i] * p2[8 + i];
                o[i] = a * pg8::fast_sigmoid(a) * li; }
#pragma unroll
            for (int i = 0; i < 16; ++i) { p2[i] = p1[i]; p1[i] = cur[i]; }
            v4u w; w.x = pk2(o[0], o[1]); w.y = pk2(o[2], o[3]); w.z = pk2(o[4], o[5]); w.w = pk2(o[6], o[7]);
            *(v4u*)(Gb + (size_t)(t0 + t) * DFF + c0) = w;
        }
    }
}

#define RLX_AGENT __ATOMIC_RELAXED, __HIP_MEMORY_SCOPE_AGENT
#define XB_TMO      128
#define XB_XCNT(j)  (256  + 64 * (j))
#define XB_XSUB(j)  (1280 + 64 * (j))
#define XB_XGEN(j)  (2304 + 64 * (j))
#define XB_TOP      3328
#define XB_TOPGEN   3392
#define XCD_BAR_WORDS 3456
#define XB_SPIN_CAP (1u << 18)

__device__ __forceinline__ unsigned xb_ld(unsigned* p)              { return __hip_atomic_load(p, __ATOMIC_RELAXED, __HIP_MEMORY_SCOPE_AGENT); }
__device__ __forceinline__ unsigned xb_add(unsigned* p, unsigned v) { return __hip_atomic_fetch_add(p, v, __ATOMIC_RELAXED, __HIP_MEMORY_SCOPE_AGENT); }
__device__ __forceinline__ unsigned xb_xcc_id() { return (unsigned)__builtin_amdgcn_s_getreg((3 << 11) | 20) & 0xFu; }
#define XB_SPIN(cond, bar) do { unsigned _sp = 0; while (cond) { __builtin_amdgcn_s_sleep(1); \
    if ((++_sp & 255u) == 0u) { if (xb_ld(&(bar)[XB_TMO])) break; if (_sp > XB_SPIN_CAP) { atomicAdd(&(bar)[XB_TMO], 1u); break; } } } } while (0)

struct XcdBarrier {
    unsigned* bar; unsigned x;
    volatile LAS unsigned* st;
};

__device__ __forceinline__ XcdBarrier xcd_barrier_post(unsigned* bar, volatile LAS unsigned* st) {
    XcdBarrier b; b.bar = bar; b.x = xb_xcc_id(); b.st = st;
    if (threadIdx.x == 0) (void)xb_add(&bar[XB_XCNT(b.x)], 1u);
    return b;
}
__device__ __forceinline__ void xcd_barrier_complete(unsigned* bar, unsigned x, unsigned& nloc, unsigned& nx) {
    const unsigned G = gridDim.x * gridDim.y * gridDim.z;
    unsigned sum, cnt, mine, sp = 0u;
    for (;;) {
        sum = 0u; cnt = 0u; mine = 0u;
#pragma unroll
        for (unsigned j = 0; j < 16; ++j) { const unsigned c = xb_ld(&bar[XB_XCNT(j)]); sum += c; cnt += (c > 0u) ? 1u : 0u; mine = (j == x) ? c : mine; }
        if (sum == G) break;
        __builtin_amdgcn_s_sleep(1);
        if ((++sp & 255u) == 0u) { if (xb_ld(&bar[XB_TMO])) break; if (sp > XB_SPIN_CAP) { atomicAdd(&bar[XB_TMO], 1u); break; } }
    }
    nloc = mine > 0u ? mine : 1u; nx = cnt > 0u ? cnt : 1u;
}

__device__ __forceinline__ void xcd_barrier(const XcdBarrier& b) {
    asm volatile("s_waitcnt vmcnt(0)" ::: "memory");
    __syncthreads();
    if (threadIdx.x == 0) {
        unsigned* bar = b.bar;
        __builtin_amdgcn_s_waitcnt(0);
        unsigned nloc = b.st[0], nx = b.st[1];
        if (nloc == 0u) { xcd_barrier_complete(bar, b.x, nloc, nx); b.st[0] = nloc; b.st[1] = nx; }
        const unsigned old = xb_add(&bar[XB_XSUB(b.x)], 1u);
        const unsigned gen = old / nloc;
        if (old + 1u == (gen + 1u) * nloc) {
            __builtin_amdgcn_fence(__ATOMIC_RELEASE, "agent");
            asm volatile("s_waitcnt vmcnt(0)" ::: "memory");
            const unsigned og = xb_add(&bar[XB_TOP], 1u);
            const unsigned tg = og / nx;
            if (og + 1u == (tg + 1u) * nx) xb_add(&bar[XB_TOPGEN], 1u);
            else XB_SPIN(xb_ld(&bar[XB_TOPGEN]) == tg, bar);
            __builtin_amdgcn_fence(__ATOMIC_ACQUIRE, "agent");
            xb_add(&bar[XB_XGEN(b.x)], 1u);
            asm volatile("s_waitcnt vmcnt(0)" ::: "memory");
        } else {
            XB_SPIN(xb_ld(&bar[XB_XGEN(b.x)]) == gen, bar);
            __builtin_amdgcn_fence(__ATOMIC_ACQUIRE, "agent");
            asm volatile("s_waitcnt vmcnt(0)" ::: "memory");
        }
    }
    __syncthreads();
}

struct Args { const float* in[18]; float* out; unsigned char* ws; };
typedef __attribute__((address_space(4))) const char* kptr_t;
#define KA_INIT kptr_t ka_ = (kptr_t)__builtin_amdgcn_kernarg_segment_ptr(); asm volatile("" : "+s"(ka_));
#define ARG_IN(i) (*(const float* const __attribute__((address_space(4)))*)(ka_ + 8 * (i)))
#define ARG_OUT (*(float* const __attribute__((address_space(4)))*)(ka_ + 8 * 18))
#define ARG_WS (*(unsigned char* const __attribute__((address_space(4)))*)(ka_ + 8 * 19))
#define PHASE_IDS KA_INIT int tid = threadIdx.x; asm volatile("" : "+v"(tid)); const int lane = tid & 63, wave = __builtin_amdgcn_readfirstlane(tid >> 6), G = gridDim.x, NGW = G * NWAVES, gw = blockIdx.x * NWAVES + wave; \
    unsigned char* const ws = ARG_WS; (void)lane; (void)gw; (void)NGW; (void)ws;
#define GRID_SYNC() do { KA_INIT XcdBarrier xb_; xb_.bar = (unsigned*)(ARG_WS + WS_BAR); xb_.x = xb_xcc_id(); xb_.st = (volatile LAS unsigned*)((LAS unsigned char*)lds_raw + LDS_MISC + 1024); xcd_barrier(xb_); } while (0)

__global__ void __launch_bounds__(NWAVES * 64, 2) fwd_mega(Args args) {
    extern __shared__ __attribute__((aligned(16))) unsigned char lds_raw[];
    LAS unsigned char* lds = (LAS unsigned char*)lds_raw;
    if (args.ws == nullptr) { cg::grid_group grid = cg::this_grid(); grid.sync(); }
    {
        volatile LAS unsigned* xst = (volatile LAS unsigned*)(lds + LDS_MISC + 1024);
        if (threadIdx.x == 0) { xst[0] = 0u; xst[1] = 0u; }
        __syncthreads();
        (void)xcd_barrier_post((unsigned*)(args.ws + WS_BAR), xst);
    }
    { PHASE_IDS phase_mod(ARG_IN(1), ARG_IN(2), (float*)(ws + WS_R1), (LAS float*)lds, tid, lane, gw, NGW); }
    GRID_SYNC();
    { PHASE_IDS phase_mod_reduce((const float*)(ws + WS_R1), ARG_IN(3), (float*)(ws + WS_MOD), blockIdx.x * (NWAVES * 64) + tid, G * NWAVES * 64); }
    GRID_SYNC();

#pragma unroll 1
    for (int l = 0; l < NLAYER; ++l) {
        for (int rep_ = 0; rep_ < ((PROBE == 4) ? 2 : 1); ++rep_) {
            if (rep_) GRID_SYNC();
            PHASE_IDS
            LAS float* scr = (LAS float*)(lds + wave * 16384);
            const float* w_in = ARG_IN(5) + (size_t)l * DMODEL * INW; const float* w_a = ARG_IN(9) + (size_t)l * 512 * DMODEL; const float* w_s = ARG_IN(10) + (size_t)l * 512 * DMODEL;
            const float* w_o = ARG_IN(11) + (size_t)l * DMODEL * DMODEL; const float* w_up = ARG_IN(13) + (size_t)l * DMODEL * UPW; const float* w_dn = ARG_IN(16) + (size_t)l * DFF * DMODEL;
            constexpr int I_IN = (DMODEL / 64) * (INW / 32), I_A = (512 / 64) * (DMODEL / 32), I_O = (DMODEL / 64) * (DMODEL / 32), I_UP = (DMODEL / 64) * (UPW / 32), I_DN = (DFF / 64) * (DMODEL / 32);
            constexpr int NITEMS = I_IN + 2 * I_A + I_O + I_UP + I_DN;
            for (int it = gw; it < NITEMS; it += NGW) {
                int r = it;
                if (r < I_IN) { transpose_item(w_in, DMODEL, INW, (bf16*)(ws + WS_WIN), scr, r, lane); continue; } r -= I_IN;
                if (r < I_A) { transpose_item(w_a, 512, DMODEL, (bf16*)(ws + WS_WA), scr, r, lane); continue; } r -= I_A;
                if (r < I_A) { transpose_item(w_s, 512, DMODEL, (bf16*)(ws + WS_WS), scr, r, lane); continue; } r -= I_A;
                if (r < I_O) { transpose_item(w_o, DMODEL, DMODEL, (bf16*)(ws + WS_WO), scr, r, lane); continue; } r -= I_O;
                if (r < I_UP) { transpose_item(w_up, DMODEL, UPW, (bf16*)(ws + WS_WUP), scr, r, lane); continue; } r -= I_UP;
                transpose_item(w_dn, DFF, DMODEL, (bf16*)(ws + WS_WDN), scr, r, lane);
            }
            const float* wsg = ARG_IN(7) + (size_t)l * 8 * 128 * 128; bf16* Wsm = (bf16*)(ws + WS_WSG);
            for (int ch = blockIdx.x * (NWAVES * 64) + tid; ch < 8 * 128 * 16; ch += G * NWAVES * 64) {
                const int i = (ch >> 4) & 127, j0 = (ch & 15) * 8;
                const f32x4 a = *(const f32x4*)(wsg + (size_t)ch * 8), b = *(const f32x4*)(wsg + (size_t)ch * 8 + 4);
                float v[8] = {a[0], a[1], a[2], a[3], b[0], b[1], b[2], b[3]};
#pragma unroll
                for (int e = 0; e < 8; ++e) if (j0 + e > i) v[e] = 0.f;
                v4u o; o.x = pk2(v[0], v[1]); o.y = pk2(v[2], v[3]); o.z = pk2(v[4], v[5]); o.w = pk2(v[6], v[7]);
                *(v4u*)(Wsm + (size_t)ch * 8) = o;
            }
            const float* gmix = ARG_IN(4) + (size_t)l * DMODEL; const float* modl = (const float*)(ws + WS_MOD) + (size_t)l * 8 * NMODW;
            const float* Xin = (l == 0) ? ARG_IN(0) : ARG_OUT; bf16* H = (bf16*)(ws + WS_H);
            for (int m = gw; m < MROWS; m += NGW) { const float* mb = modl + (size_t)(m >> 11) * NMODW;
                norm_mod_row(Xin + (size_t)m * DMODEL, gmix, mb + DMODEL, mb, H + (size_t)m * DMODEL, lane); }
        }
        GRID_SYNC();
        for (int rep_ = 0; rep_ < ((PROBE == 1) ? 2 : 1); ++rep_) {
            if (rep_) GRID_SYNC();
            KA_INIT unsigned char* const ws = ARG_WS;
            pg8::Gemm g{(bf16*)(ws + WS_H), (bf16*)(ws + WS_WIN), MROWS, INW, DMODEL, DMODEL}; pg8::StaticOrder S; S.init(MROWS, INW, (int)gridDim.x, (int)blockIdx.x);
            pg8::EpiIn E{(bf16*)(ws + WS_R1), (float*)(ws + WS_KMS) + (size_t)l * 65536};
            pg8::gemm_phase<pg8::EpiIn, pg8::StaticOrder, true, true>(lds, g, S, E);
        }
        GRID_SYNC();
        {
            { KA_INIT unsigned char* const ws = ARG_WS; bf16* P = (bf16*)(ws + WS_R1); const float* kms = (const float*)(ws + WS_KMS) + (size_t)l * 65536;
              for (int i = blockIdx.x; i < 256; i += gridDim.x) {
                const int bh = i >> 2, s = i & 3;
#pragma unroll 1
                for (int k = 0; k < 2; ++k) { const int qb = k ? s : 7 - s;
                    attn_body::attn_unit<8>(bh >> 3, bh & 7, qb, (const attn_body::bf16*)(P + COL_Q), (const attn_body::bf16*)(P + COL_K), (const attn_body::bf16*)(P + COL_V), (attn_body::bf16*)(P + COL_Q),
                                            kms + (size_t)bh * 512, (char*)lds_raw); }
              } }
            __syncthreads();
            { PHASE_IDS
              const float* gsgu = ARG_IN(6) + (size_t)l * 512; const float* bs = ARG_IN(8) + (size_t)l * 8 * 128;
              for (int i = blockIdx.x; i < 256; i += G) sgu_unit(i, (bf16*)(ws + WS_R1), gsgu, (const bf16*)(ws + WS_WSG), bs, lds, tid, lane, wave); }
        }
        GRID_SYNC();
#pragma unroll 1
        for (int br_ = 0; br_ < ((PROBE == 2) ? 4 : 2); ++br_) { const int br = br_ & 1;
            { KA_INIT unsigned char* const ws = ARG_WS; bf16* P = (bf16*)(ws + WS_R1);
              pg8::Gemm g{br ? P + COL_U : P + COL_Q, br ? (bf16*)(ws + WS_WS) : (bf16*)(ws + WS_WA), MROWS, DMODEL, 512, INW}; pg8::StaticOrder S; S.init(MROWS, DMODEL, (int)gridDim.x, (int)blockIdx.x);
              pg8::EpiBranch E{br ? P + COL_GS : P + COL_GA, (bf16*)(ws + WS_MG), br};
              pg8::gemm_phase<pg8::EpiBranch, pg8::StaticOrder, true, true>(lds, g, S, E); }
            GRID_SYNC();
        }
        {
            KA_INIT unsigned char* const ws = ARG_WS; const float* modl = (const float*)(ws + WS_MOD) + (size_t)l * 8 * NMODW;
            pg8::Gemm g{(bf16*)(ws + WS_MG), (bf16*)(ws + WS_WO), MROWS, DMODEL, DMODEL, DMODEL}; pg8::StaticOrder S; S.init(MROWS, DMODEL, (int)gridDim.x, (int)blockIdx.x);
            pg8::EpiRes E{(l == 0) ? ARG_IN(0) : (const float*)ARG_OUT, ARG_OUT, modl + 2 * DMODEL};
            pg8::gemm_phase<pg8::EpiRes, pg8::StaticOrder, true, true>(lds, g, S, E);
        }
        GRID_SYNC();
        if (PROBE == 5) { for (int rep_ = 0; rep_ < 10; ++rep_) GRID_SYNC(); }
        for (int rep_ = 0; rep_ < ((PROBE == 6) ? 2 : 1); ++rep_) {
            if (rep_) GRID_SYNC();
            PHASE_IDS
            const float* gffn = ARG_IN(12) + (size_t)l * DMODEL; const float* modl = (const float*)(ws + WS_MOD) + (size_t)l * 8 * NMODW; const float* X = ARG_OUT; bf16* H = (bf16*)(ws + WS_H);
            for (int m = gw; m < MROWS; m += NGW) { const float* mb = modl + (size_t)(m >> 11) * NMODW;
                norm_mod_row(X + (size_t)m * DMODEL, gffn, mb + 4 * DMODEL, mb + 3 * DMODEL, H + (size_t)m * DMODEL, lane); }
        }
        GRID_SYNC();
        for (int rep_ = 0; rep_ < ((PROBE == 1) ? 2 : 1); ++rep_) {
            if (rep_) GRID_SYNC();
            KA_INIT unsigned char* const ws = ARG_WS;
            pg8::Gemm g{(bf16*)(ws + WS_H), (bf16*)(ws + WS_WUP), MROWS, UPW, DMODEL, DMODEL}; pg8::StaticOrder S; S.init(MROWS, UPW, (int)gridDim.x, (int)blockIdx.x);
            pg8::EpiPlain E{(bf16*)(ws + WS_R1), UPW};
            pg8::gemm_phase<pg8::EpiPlain, pg8::StaticOrder, true, true>(lds, g, S, E);
        }
        GRID_SYNC();
        for (int rep_ = 0; rep_ < ((PROBE == 3) ? 2 : 1); ++rep_) { if (rep_) GRID_SYNC(); PHASE_IDS
            phase_conv((const bf16*)(ws + WS_R1), ARG_IN(14) + (size_t)l * 3 * UPW, ARG_IN(15) + (size_t)l * UPW, (bf16*)(ws + WS_G), blockIdx.x * (NWAVES * 64) + tid, G * NWAVES * 64); }
        GRID_SYNC();
        {
            KA_INIT unsigned char* const ws = ARG_WS; const float* modl = (const float*)(ws + WS_MOD) + (size_t)l * 8 * NMODW;
            pg8::Gemm g{(bf16*)(ws + WS_G), (bf16*)(ws + WS_WDN), MROWS, DMODEL, DFF, DFF}; pg8::StaticOrder S; S.init(MROWS, DMODEL, (int)gridDim.x, (int)blockIdx.x);
            pg8::EpiRes E{ARG_OUT, ARG_OUT, modl + 5 * DMODEL};
            pg8::gemm_phase<pg8::EpiRes, pg8::StaticOrder, true, true>(lds, g, S, E);
        }
        GRID_SYNC();
    }
    { PHASE_IDS float* X = ARG_OUT; const float* gf = ARG_IN(17); for (int m = gw; m < MROWS; m += NGW) norm_final_row(X + (size_t)m * DMODEL, gf, X + (size_t)m * DMODEL, lane); }
}

extern "C" void kernel_launch(void* const* d_in, const int* in_sizes, int n_in, void* d_out, int out_size, void* d_ws, size_t ws_size, hipStream_t stream) {
    static int grid = 0;
    if (grid == 0) {
        if (n_in != 18 || in_sizes[0] != MROWS * DMODEL || out_size != MROWS * DMODEL || ws_size < WS_END) {
            fprintf(stderr, "kernel_launch: unexpected shapes (n_in %d, in0 %d, out %d, ws %zu); nothing launched\n", n_in, n_in > 0 ? in_sizes[0] : -1, out_size, ws_size); grid = -1; return; }
        int dev = 0, cus = 0, per_cu = 0;
        hipGetDevice(&dev); hipDeviceGetAttribute(&cus, hipDeviceAttributeMultiprocessorCount, dev);
        if (hipFuncSetAttribute((const void*)fwd_mega, hipFuncAttributeMaxDynamicSharedMemorySize, LDS_BYTES) != hipSuccess) { fprintf(stderr, "kernel_launch: hipFuncSetAttribute failed\n"); grid = -1; return; }
        if (hipOccupancyMaxActiveBlocksPerMultiprocessor(&per_cu, (const void*)fwd_mega, NWAVES * 64, LDS_BYTES) != hipSuccess || per_cu < 1) { fprintf(stderr, "kernel_launch: occupancy query gave %d\n", per_cu); per_cu = 1; }
        (void)hipGetLastError();
        grid = cus * per_cu;
        fprintf(stderr, "kernel_launch: grid %d (%d CUs x %d)\n", grid, cus, per_cu);
    }
    if (grid < 0) return;
    hipMemsetAsync((char*)d_ws + WS_BAR, 0, WS_BAR_BYTES, stream);
    Args a{};
    for (int i = 0; i < 18; ++i) a.in[i] = (const float*)d_in[i];
    a.out = (float*)d_out; a.ws = (unsigned char*)d_ws;
    void* kargs[] = {&a};
    hipError_t e = hipLaunchCooperativeKernel((const void*)fwd_mega, dim3(grid), dim3(NWAVES * 64), kargs, LDS_BYTES, stream);
    if (e != hipSuccess) fprintf(stderr, "kernel_launch: cooperative launch failed: %s (grid %d)\n", hipGetErrorString(e), grid);
}
```

```cpp
#include <hip/hip_runtime.h>
#include <hip/hip_cooperative_groups.h>
#include <hip/hip_bf16.h>
#include <cstdio>
#include <cstdint>
#include <cmath>
namespace cg = cooperative_groups;
namespace pg8 {
#define PG8_LAS __attribute__((address_space(3)))
typedef unsigned short bf16_t;
typedef short bf16x8 __attribute__((ext_vector_type(8)));
typedef float f32x4 __attribute__((ext_vector_type(4)));
typedef unsigned u32x4 __attribute__((ext_vector_type(4)));
constexpr int BM = 256, BK = 64, HALF = 128, HTB = HALF * BK * 2  , STAGE_BYTES = 8 * HTB, NXCD = 8, WGM = 8;

__host__ __device__ __forceinline__ int lds_byte(int r, int c) { const int st = (r >> 4) * 2 + (c >> 5), rr = r & 15, cc = c & 31, ob = rr * 64 + cc * 2; return st * 1024 + (ob ^ (((ob >> 9) & 1) << 5)); }
__host__ __device__ __forceinline__ void stage_rc(int b, int& R, int& C) { const int st = b / 1024, sb = b % 1024, swz = sb ^ (((sb >> 9) & 1) << 5); R = (st >> 1) * 16 + swz / 64; C = (st & 1) * 32 + (swz % 64) / 2; }
__host__ __device__ __forceinline__ int perm32(int rho) { const int n = rho >> 4, i = rho & 15; return 8 * (i >> 2) + 4 * n + (i & 3); }

struct Unit { int pm, pn, br; };
struct Gemm { const bf16_t* A; const bf16_t* Bt; int M, N, K, lda; const bf16_t* A2; const bf16_t* Bt2; };

struct StaticOrder {
    int nM, nN, nwg, G, c;
    __host__ __device__ void init(int M, int N, int G_, int c_) { nM = M / BM; nN = N / BM; nwg = nM * nN; G = G_; c = c_; }
    __host__ __device__ bool next(int i, Unit& u) const {
        const long L = (long)i * G + c; if (L >= nwg) return false;
        int wgid = (int)L; { const int q = nwg / NXCD, r = nwg % NXCD, xcd = wgid % NXCD, off = wgid / NXCD; wgid = (xcd < r ? xcd * (q + 1) : r * (q + 1) + (xcd - r) * q) + off; }
        const int nig = WGM * nN, gid = wgid / nig, fm = gid * WGM, gsz = (nM - fm) < WGM ? (nM - fm) : WGM;
        u.pm = fm + ((wgid % nig) % gsz); u.pn = (wgid % nig) / gsz; u.br = 0; return true;
    }
    __device__ __forceinline__ void a_ready(const Unit&) const {}
    __device__ __forceinline__ void done(const Unit&) const {}
};

struct DualOrder {
    StaticOrder so;
    __host__ __device__ void init(int M, int N, int G_, int c_) { so.init(M, N, G_, c_); }
    __host__ __device__ bool next(int i, Unit& u) const { if (!so.next(i >> 1, u)) return false; u.br = i & 1; return true; }
    __device__ __forceinline__ void a_ready(const Unit&) const {}
    __device__ __forceinline__ void done(const Unit&) const {}
};
__device__ __forceinline__ unsigned cvt_pk_bf16(float lo, float hi) { unsigned r; asm volatile("v_cvt_pk_bf16_f32 %0, %1, %2" : "=v"(r) : "v"(lo), "v"(hi)); return r; }
typedef float f32x2 __attribute__((ext_vector_type(2)));
__device__ __forceinline__ float fast_sigmoid(float x) { return __builtin_amdgcn_rcpf(1.0f + __builtin_amdgcn_exp2f(-1.4426950408889634f * x)); }
__device__ __forceinline__ float gelu_tanh(float x) { const float z2 = 1.5957691216057308f * (x + 0.044715f * x * x * x); return x * fast_sigmoid(z2); }
__device__ __forceinline__ float bf_lo(unsigned w) { return __uint_as_float(w << 16); }
__device__ __forceinline__ float bf_hi(unsigned w) { return __uint_as_float(w & 0xffff0000u); }
constexpr float QSCALE = 0.125f * 1.4426950408889634f;

struct EpiIn {
    static constexpr bool PERM = true, AFTER_DRAIN = false, CARRY = false;
    bf16_t* P; float* kms;
    __device__ __forceinline__ void operator()(const f32x4 (&acc)[2][2][4][2], const Unit& u, int wr, int wc, int fr, int fq) const {
        const int pn = u.pn;
        const int row0 = u.pm * BM + wr * 64 + fr, col0 = pn * BM + wc * 32 + 8 * fq;
        f32x4 ks[2][2];
#pragma unroll
        for (int a = 0; a < 2; ++a)
#pragma unroll
            for (int b = 0; b < 2; ++b) ks[a][b] = (f32x4){0.f, 0.f, 0.f, 0.f};
#pragma unroll
        for (int ai = 0; ai < 2; ++ai)
#pragma unroll
            for (int m = 0; m < 4; ++m) { bf16_t* rowp = P + (size_t)(row0 + ai * HALF + m * 16) * 4608 + col0;
#pragma unroll
                for (int bj = 0; bj < 2; ++bj) { f32x4 v0 = acc[ai][bj][m][0], v1 = acc[ai][bj][m][1];
                    if (pn < 2) { v0 = v0 * QSCALE; v1 = v1 * QSCALE; }
                    else if (pn < 4) { ks[bj][0] += v0; ks[bj][1] += v1; }
                    else if (pn < 6) { }
                    else if (pn < 10) {
#pragma unroll
                        for (int i = 0; i < 4; ++i) { v0[i] = gelu_tanh(v0[i]); v1[i] = gelu_tanh(v1[i]); } }
                    else {
#pragma unroll
                        for (int i = 0; i < 4; ++i) { v0[i] = fast_sigmoid(v0[i]); v1[i] = fast_sigmoid(v1[i]); } }
                    u32x4 w; w.x = cvt_pk_bf16(v0[0], v0[1]); w.y = cvt_pk_bf16(v0[2], v0[3]); w.z = cvt_pk_bf16(v1[0], v1[1]); w.w = cvt_pk_bf16(v1[2], v1[3]);
                    *(u32x4*)(rowp + bj * HALF) = w; } }
        if (pn >= 2 && pn < 4) {
            const int b = u.pm >> 3, blk = u.pm & 7;
#pragma unroll
            for (int bj = 0; bj < 2; ++bj)
#pragma unroll
                for (int n = 0; n < 2; ++n)
#pragma unroll
                    for (int i = 0; i < 4; ++i) { float s = ks[bj][n][i];
                        s += __shfl_xor(s, 1); s += __shfl_xor(s, 2); s += __shfl_xor(s, 4); s += __shfl_xor(s, 8);
                        if (fr == 0) { const int kc = (pn - 2) * 256 + bj * 128 + wc * 32 + 8 * fq + 4 * n + i; const int h = kc >> 6, d = kc & 63;
                            kms[(size_t)wr * 32768 + ((size_t)((b * 8 + h) * 8 + blk)) * 64 + d] = s; } }
        }
    }
};

struct EpiBranch {
    static constexpr bool PERM = true, AFTER_DRAIN = false, CARRY = false;
    const bf16_t* Gt; bf16_t* Mg; int accum;
    __device__ __forceinline__ void operator()(const f32x4 (&acc)[2][2][4][2], const Unit& u, int wr, int wc, int fr, int fq) const {
        const int row0 = u.pm * BM + wr * 64 + fr, col0 = u.pn * BM + wc * 32 + 8 * fq;
#pragma unroll
        for (int ai = 0; ai < 2; ++ai)
#pragma unroll
            for (int m = 0; m < 4; ++m) { const size_t row = (size_t)(row0 + ai * HALF + m * 16);
#pragma unroll
                for (int bj = 0; bj < 2; ++bj) { const int col = col0 + bj * HALF;
                    const u32x4 g = *(const u32x4*)(Gt + row * 4608 + col);
                    const f32x4 a0 = acc[ai][bj][m][0], a1 = acc[ai][bj][m][1];
                    float o0 = bf_lo(g.x) * a0[0], o1 = bf_hi(g.x) * a0[1], o2 = bf_lo(g.y) * a0[2], o3 = bf_hi(g.y) * a0[3];
                    float o4 = bf_lo(g.z) * a1[0], o5 = bf_hi(g.z) * a1[1], o6 = bf_lo(g.w) * a1[2], o7 = bf_hi(g.w) * a1[3];
                    bf16_t* mp = Mg + row * 1024 + col;
                    if (accum) { const u32x4 p = *(const u32x4*)mp;
                        o0 += bf_lo(p.x); o1 += bf_hi(p.x); o2 += bf_lo(p.y); o3 += bf_hi(p.y); o4 += bf_lo(p.z); o5 += bf_hi(p.z); o6 += bf_lo(p.w); o7 += bf_hi(p.w); }
                    u32x4 w; w.x = cvt_pk_bf16(o0, o1); w.y = cvt_pk_bf16(o2, o3); w.z = cvt_pk_bf16(o4, o5); w.w = cvt_pk_bf16(o6, o7);
                    *(u32x4*)mp = w; } }
    }
};

struct EpiRes {
    static constexpr bool PERM = false, AFTER_DRAIN = false, CARRY = false;
    const float* base; float* out; const float* gate;
    __device__ __forceinline__ void operator()(const f32x4 (&acc)[2][2][4][2], const Unit& u, int wr, int wc, int fr, int fq) const {
        const float* gp = gate + (size_t)(u.pm >> 3) * 6144;
        const int col0 = u.pn * BM + wc * 32 + 4 * fq;
#pragma unroll
        for (int bj = 0; bj < 2; ++bj)
#pragma unroll
            for (int n = 0; n < 2; ++n) { const int c = col0 + bj * HALF + n * 16; const f32x4 g4 = *(const f32x4*)(gp + c);
#pragma unroll
                for (int ai = 0; ai < 2; ++ai)
#pragma unroll
                    for (int m = 0; m < 4; ++m) { const size_t off = (size_t)(u.pm * BM + ai * HALF + wr * 64 + m * 16 + fr) * 1024 + c;
                        const f32x4 bs = *(const f32x4*)(base + off); *(f32x4*)(out + off) = bs + g4 * acc[ai][bj][m][n]; } }
    }
};

struct EpiPlain {
    static constexpr bool PERM = true, AFTER_DRAIN = false, CARRY = false;
    bf16_t* O; int ldc;
    __device__ __forceinline__ void operator()(const f32x4 (&acc)[2][2][4][2], const Unit& u, int wr, int wc, int fr, int fq) const {
        const int row0 = u.pm * BM + wr * 64 + fr, col0 = u.pn * BM + wc * 32 + 8 * fq;
#pragma unroll
        for (int ai = 0; ai < 2; ++ai)
#pragma unroll
            for (int m = 0; m < 4; ++m) { bf16_t* rowp = O + (size_t)(row0 + ai * HALF + m * 16) * ldc + col0;
#pragma unroll
                for (int bj = 0; bj < 2; ++bj) { const f32x4 v0 = acc[ai][bj][m][0], v1 = acc[ai][bj][m][1];
                    u32x4 w; w.x = cvt_pk_bf16(v0[0], v0[1]); w.y = cvt_pk_bf16(v0[2], v0[3]); w.z = cvt_pk_bf16(v1[0], v1[1]); w.w = cvt_pk_bf16(v1[2], v1[3]);
                    *(u32x4*)(rowp + bj * HALF) = w; } }
    }
};

struct EpiBranch2 {
    static constexpr bool PERM = true, AFTER_DRAIN = false, CARRY = true;
    const bf16_t* P; bf16_t* Mg;
    __device__ __forceinline__ void mid(f32x4 (&acc)[2][2][4][2], const Unit& u, int wr, int wc, int fr, int fq) const {
        const int row0 = u.pm * BM + wr * 64 + fr, col0 = u.pn * BM + wc * 32 + 8 * fq;
#pragma unroll
        for (int ai = 0; ai < 2; ++ai)
#pragma unroll
            for (int m = 0; m < 4; ++m) { const bf16_t* rp = P + (size_t)(row0 + ai * HALF + m * 16) * 4608 + col0;
#pragma unroll
                for (int bj = 0; bj < 2; ++bj) { const u32x4 ga = *(const u32x4*)(rp + 2560 + bj * HALF), gs = *(const u32x4*)(rp + 3584 + bj * HALF);
#pragma unroll
                    for (int i = 0; i < 4; ++i) { const float r0 = bf_lo(ga[i]) * __builtin_amdgcn_rcpf(fmaxf(bf_lo(gs[i]), 1e-30f)), r1 = bf_hi(ga[i]) * __builtin_amdgcn_rcpf(fmaxf(bf_hi(gs[i]), 1e-30f));
                        acc[ai][bj][m][i >> 1][(i & 1) * 2] *= r0; acc[ai][bj][m][i >> 1][(i & 1) * 2 + 1] *= r1; } } }
    }
    __device__ __forceinline__ void operator()(const f32x4 (&acc)[2][2][4][2], const Unit& u, int wr, int wc, int fr, int fq) const {
        const int row0 = u.pm * BM + wr * 64 + fr, col0 = u.pn * BM + wc * 32 + 8 * fq;
#pragma unroll
        for (int ai = 0; ai < 2; ++ai)
#pragma unroll
            for (int m = 0; m < 4; ++m) { const size_t row = (size_t)(row0 + ai * HALF + m * 16);
#pragma unroll
                for (int bj = 0; bj < 2; ++bj) { const int col = col0 + bj * HALF;
                    const u32x4 g = *(const u32x4*)(P + row * 4608 + 3584 + col);
                    const f32x4 a0 = acc[ai][bj][m][0], a1 = acc[ai][bj][m][1];
                    u32x4 w; w.x = cvt_pk_bf16(bf_lo(g.x) * a0[0], bf_hi(g.x) * a0[1]); w.y = cvt_pk_bf16(bf_lo(g.y) * a0[2], bf_hi(g.y) * a0[3]);
                    w.z = cvt_pk_bf16(bf_lo(g.z) * a1[0], bf_hi(g.z) * a1[1]); w.w = cvt_pk_bf16(bf_lo(g.w) * a1[2], bf_hi(g.w) * a1[3]);
                    *(u32x4*)(Mg + row * 1024 + col) = w; } }
    }
};
template <class Epi, class Sched, bool ALIGN_EPI = false, bool SP2 = false>
__device__ __forceinline__ void gemm_phase(PG8_LAS unsigned char* lds, const Gemm g, const Sched& S, const Epi& E) {
    int tid_l = threadIdx.x; asm volatile("" : "+v"(tid_l)); const int tid = tid_l, wid = __builtin_amdgcn_readfirstlane(tid >> 6), lane = tid & 63, wr = wid >> 2, wc = wid & 3, fr = lane & 15, fq = lane >> 4;
    const int K = g.K, nt = K / BK, lda = g.lda;
    unsigned voffA[2], voffB[2];
#pragma unroll
    for (int i = 0; i < 2; ++i) { int R, C; stage_rc(tid * 16 + i * 8192, R, C); const int Rb = Epi::PERM ? ((R & ~31) + perm32(R & 31)) : R;
        voffA[i] = (unsigned)(R * lda + C) * 2u; voffB[i] = (unsigned)(Rb * K + C) * 2u; }
    const size_t kstep = (size_t)(BK * 2);
    const size_t hstep = (size_t)HALF * K * 2;
    const size_t tstep = 2 * hstep; const size_t hstepA = (size_t)HALF * lda * 2, tstepA = 2 * hstepA;
    const unsigned ldsw = (unsigned)wid * 1024u;
    const int aoff = lds_byte(wr * 64 + fr, fq * 8), boff = lds_byte(wc * 32 + fr, fq * 8);
#define PG8_SA(b, h) (((b) * 2 + (h)) * HTB)
#define PG8_SB(b, h) ((4 + (b) * 2 + (h)) * HTB)
#define PG8_STAGE(bufoff, gbase, voff) do { _Pragma("unroll") for (int _i = 0; _i < 2; ++_i) \
        __builtin_amdgcn_global_load_lds((const unsigned*)((const char*)(gbase) + (voff)[_i]), (PG8_LAS unsigned*)(lds + (bufoff) + ldsw + _i * 8192), 16, 0, 0); } while (0)
#define PG8_LDA(dst, b, h) do { _Pragma("unroll") for (int m = 0; m < 4; ++m) _Pragma("unroll") for (int k = 0; k < 2; ++k) dst[m][k] = *(const PG8_LAS bf16x8*)(lds + PG8_SA(b, h) + aoff + m * 2048 + k * 1024); } while (0)
#define PG8_LDB(dst, b, h) do { _Pragma("unroll") for (int n = 0; n < 2; ++n) _Pragma("unroll") for (int k = 0; k < 2; ++k) dst[n][k] = *(const PG8_LAS bf16x8*)(lds + PG8_SB(b, h) + boff + n * 2048 + k * 1024); } while (0)
#define PG8_MMA(ai, bj, At, Bt) do { __builtin_amdgcn_s_setprio(1); _Pragma("unroll") for (int m = 0; m < 4; ++m) _Pragma("unroll") for (int n = 0; n < 2; ++n) _Pragma("unroll") for (int k = 0; k < 2; ++k) \
        acc[ai][bj][m][n] = __builtin_amdgcn_mfma_f32_16x16x32_bf16(Bt[n][k], At[m][k], acc[ai][bj][m][n], 0, 0, 0); __builtin_amdgcn_s_setprio(0); } while (0)
#define PG8_WAIT_V(n) asm volatile("s_waitcnt vmcnt(" #n ")" ::: "memory")
#define PG8_WAIT_L(n) asm volatile("s_waitcnt lgkmcnt(" #n ")" ::: "memory")
#define PG8_BAR __builtin_amdgcn_s_barrier()
#define PG8_SCHED __builtin_amdgcn_sched_barrier(0)
#define PG8_APTR(u) ((const char*)((u).br ? g.A2 : g.A) + (size_t)(u).pm * tstepA)
#define PG8_BPTR(u) ((const char*)((u).br ? g.Bt2 : g.Bt) + (size_t)(u).pn * tstep)
    Unit cur, nxt; int ui = 0;
    if (!S.next(0, cur)) return;
    f32x4 acc[2][2][4][2];
#pragma unroll
    for (int a = 0; a < 2; ++a)
#pragma unroll
        for (int b = 0; b < 2; ++b)
#pragma unroll
            for (int m = 0; m < 4; ++m)
#pragma unroll
                for (int n = 0; n < 2; ++n) acc[a][b][m][n] = (f32x4){0.f, 0.f, 0.f, 0.f};
    bf16x8 At[4][2], B0[2][2], B1[2][2];
    const char* cA = PG8_APTR(cur); const char* cB = PG8_BPTR(cur);
    S.a_ready(cur);
    if constexpr (SP2) {
        PG8_STAGE(PG8_SB(0, 0), cB, voffB); PG8_STAGE(PG8_SB(0, 1), cB + hstep, voffB); PG8_STAGE(PG8_SA(0, 0), cA, voffA); PG8_STAGE(PG8_SA(0, 1), cA + hstepA, voffA);
        if (wr == 1) PG8_BAR;
        PG8_WAIT_V(2); PG8_BAR;
        PG8_STAGE(PG8_SB(1, 0), cB + kstep, voffB); PG8_STAGE(PG8_SA(1, 0), cA + kstep, voffA); PG8_STAGE(PG8_SB(1, 1), cB + hstep + kstep, voffB);
        PG8_WAIT_V(6); PG8_BAR;
    } else {
        PG8_STAGE(PG8_SB(0, 0), cB, voffB); PG8_STAGE(PG8_SA(0, 0), cA, voffA); PG8_STAGE(PG8_SB(0, 1), cB + hstep, voffB); PG8_STAGE(PG8_SA(0, 1), cA + hstepA, voffA);
        if (wr == 1) PG8_BAR;
        PG8_WAIT_V(4); PG8_BAR;
        PG8_STAGE(PG8_SB(1, 0), cB + kstep, voffB); PG8_STAGE(PG8_SA(1, 0), cA + kstep, voffA); PG8_STAGE(PG8_SB(1, 1), cB + hstep + kstep, voffB);
        PG8_WAIT_V(6); PG8_BAR;
    }
    for (;;) {
        const bool has_next = S.next(ui + 1, nxt);
        const char* nA = has_next ? PG8_APTR(nxt) : cA; const char* nB = has_next ? PG8_BPTR(nxt) : cB;
        for (int t = 0; t < nt; t += 2) {
            const bool last = (t == nt - 2);
            const char* a1 = cA + (size_t)(t + 1) * kstep;
            const char* a2 = last ? nA : cA + (size_t)(t + 2) * kstep; const char* b2 = last ? nB : cB + (size_t)(t + 2) * kstep;
            const char* a3 = a2 + kstep; const char* b3 = b2 + kstep;
            if (last && has_next) S.a_ready(nxt);
            if constexpr (SP2) {
            PG8_LDB(B0, 0, 0); PG8_LDB(B1, 0, 1); PG8_SCHED; PG8_LDA(At, 0, 0); PG8_STAGE(PG8_SA(1, 1), a1 + hstepA, voffA);
            PG8_WAIT_V(8); PG8_WAIT_L(0); PG8_BAR; PG8_MMA(0, 0, At, B0); PG8_MMA(0, 1, At, B1); PG8_BAR; PG8_SCHED;
            PG8_LDA(At, 0, 1); PG8_STAGE(PG8_SB(0, 0), b2, voffB); PG8_STAGE(PG8_SB(0, 1), b2 + hstep, voffB); PG8_STAGE(PG8_SA(0, 0), a2, voffA);
            PG8_WAIT_V(8); PG8_WAIT_L(0); PG8_BAR; PG8_MMA(1, 0, At, B0); PG8_MMA(1, 1, At, B1); PG8_BAR; PG8_SCHED;
            PG8_LDB(B0, 1, 0); PG8_LDB(B1, 1, 1); PG8_SCHED; PG8_LDA(At, 1, 0); PG8_STAGE(PG8_SA(0, 1), a2 + hstepA, voffA);
            PG8_WAIT_V(8); PG8_WAIT_L(0); PG8_BAR; PG8_MMA(0, 0, At, B0); PG8_MMA(0, 1, At, B1); PG8_BAR; PG8_SCHED;
            PG8_LDA(At, 1, 1); PG8_STAGE(PG8_SB(1, 0), b3, voffB); PG8_STAGE(PG8_SB(1, 1), b3 + hstep, voffB); PG8_STAGE(PG8_SA(1, 0), a3, voffA);
            PG8_WAIT_V(8); PG8_WAIT_L(0); PG8_BAR; PG8_MMA(1, 0, At, B0); PG8_MMA(1, 1, At, B1); PG8_BAR; PG8_SCHED;
            } else {
            PG8_LDB(B0, 0, 0); PG8_SCHED; PG8_LDA(At, 0, 0); PG8_STAGE(PG8_SA(1, 1), a1 + hstepA, voffA);
            PG8_WAIT_L(8); PG8_BAR; PG8_WAIT_L(0); PG8_MMA(0, 0, At, B0); PG8_BAR; PG8_SCHED;
            PG8_LDB(B1, 0, 1); PG8_STAGE(PG8_SB(0, 0), b2, voffB);
            PG8_BAR; PG8_WAIT_L(0); PG8_MMA(0, 1, At, B1); PG8_BAR;
            PG8_LDA(At, 0, 1); PG8_STAGE(PG8_SA(0, 0), a2, voffA);
            PG8_BAR; PG8_WAIT_L(0); PG8_MMA(1, 0, At, B0); PG8_BAR; PG8_SCHED;
            PG8_STAGE(PG8_SB(0, 1), b2 + hstep, voffB);
            PG8_WAIT_V(6); PG8_BAR; PG8_MMA(1, 1, At, B1); PG8_BAR;
            PG8_LDB(B0, 1, 0); PG8_SCHED; PG8_LDA(At, 1, 0); PG8_STAGE(PG8_SA(0, 1), a2 + hstepA, voffA);
            PG8_WAIT_L(8); PG8_BAR; PG8_WAIT_L(0); PG8_MMA(0, 0, At, B0); PG8_BAR; PG8_SCHED;
            PG8_LDB(B1, 1, 1); PG8_STAGE(PG8_SB(1, 0), b3, voffB);
            PG8_BAR; PG8_WAIT_L(0); PG8_MMA(0, 1, At, B1); PG8_BAR;
            PG8_LDA(At, 1, 1); PG8_STAGE(PG8_SA(1, 0), a3, voffA);
            PG8_BAR; PG8_WAIT_L(0); PG8_MMA(1, 0, At, B0); PG8_BAR; PG8_SCHED;
            PG8_STAGE(PG8_SB(1, 1), b3 + hstep, voffB);
            PG8_WAIT_V(6); PG8_BAR; PG8_MMA(1, 1, At, B1); PG8_BAR;
            }
        }
        if constexpr (ALIGN_EPI) { if (wr == 0) PG8_BAR; }
        if constexpr (!Epi::AFTER_DRAIN) { if constexpr (Epi::CARRY) { if (cur.br == 0) E.mid(acc, cur, wr, wc, fr, fq); else E(acc, cur, wr, wc, fr, fq); } else E(acc, cur, wr, wc, fr, fq); S.done(cur); }
        if (!has_next) break;
        if (!(Epi::CARRY && cur.br == 0))
#pragma unroll
        for (int a = 0; a < 2; ++a)
#pragma unroll
            for (int b = 0; b < 2; ++b)
#pragma unroll
                for (int m = 0; m < 4; ++m)
#pragma unroll
                    for (int n = 0; n < 2; ++n) acc[a][b][m][n] = (f32x4){0.f, 0.f, 0.f, 0.f};
        cur = nxt; cA = nA; cB = nB; ++ui;
        if constexpr (ALIGN_EPI) { if (wr == 1) PG8_BAR; }
    }
    PG8_WAIT_V(0);
    if constexpr (!ALIGN_EPI) { if (wr == 0) PG8_BAR; }
    PG8_BAR;
    if constexpr (Epi::AFTER_DRAIN) { E.fused(acc, cur, wr, wc, fr, fq, lds, wid, lane); S.done(cur); }
#undef PG8_SA
#undef PG8_SB
#undef PG8_STAGE
#undef PG8_LDA
#undef PG8_LDB
#undef PG8_MMA
#undef PG8_WAIT_V
#undef PG8_WAIT_L
#undef PG8_BAR
#undef PG8_SCHED
}
}

namespace attn_body {
using bf16=__hip_bfloat16;
using bf16x8=__attribute__((ext_vector_type(8)))short;
using s16x4=__attribute__((ext_vector_type(4)))short;
using f32x16=__attribute__((ext_vector_type(16)))float;
using u32x4=__attribute__((ext_vector_type(4)))unsigned;
using f32x4v=__attribute__((ext_vector_type(4)))float;
__device__ __forceinline__ float bf2f(short v){return __uint_as_float(((unsigned)(unsigned short)v)<<16);}
constexpr int BATCH=8,NHEAD=8,SEQ=2048,D=64,DM=4608;
constexpr int NW=8,QBLK=32,QB=QBLK*NW,KVBLK=64,NQB=SEQ/QB;
constexpr int ATTN_PITCH=DM, ATTN_UNIT_ROWS=QB, OPITCH=512;
__device__ __forceinline__ int crow(int r,int hi){return (r&3)+8*(r>>2)+4*hi;}
#define SBAR() __builtin_amdgcn_sched_barrier(0)
__device__ __forceinline__ void cmask(f32x16&p0,f32x16&p1,int jb,int qrel,int hi){
  const float NEG=-INFINITY; int kb=64*jb+4*hi;
  #pragma unroll
  for(int r=0;r<16;++r){int kv=kb+(r&3)+8*(r>>2); if(kv>qrel)p0[r]=NEG; if(kv+32>qrel)p1[r]=NEG;}
}

constexpr int NSLOT=3, SLOTB=8192;
constexpr int LDS_K=0, LDS_V=NSLOT*SLOTB, LDS_WS=2*NSLOT*SLOTB, LDS_OST=LDS_WS+NW*64*4, LDS_BYTES=LDS_OST+NW*4096;
constexpr float C2=0.125f*1.4426950408889634f;
__device__ __forceinline__ void glds16(const void*gsrc,unsigned lds_dst){unsigned keep;
  asm volatile("s_mov_b32 %0, m0\n\ts_mov_b32 m0, %2\n\ts_nop 0\n\tglobal_load_lds_dwordx4 %1, off\n\ts_mov_b32 m0, %0":"=&s"(keep):"v"(gsrc),"s"(lds_dst):"memory");}
__device__ __forceinline__ float max3f(float a,float b,float c){float r;asm("v_max3_f32 %0, %1, %2, %3":"=v"(r):"v"(a),"v"(b),"v"(c));return r;}
__device__ __forceinline__ float max2f(float a,float b){float r;asm("v_max_f32_e32 %0, %1, %2":"=v"(r):"v"(a),"v"(b));return r;}
__device__ __forceinline__ float fadd_s(float a,float b){float r;asm("v_add_f32_e32 %0, %1, %2":"=v"(r):"v"(a),"v"(b));return r;}
__device__ __forceinline__ float fsub_s(float a,float b){float r;asm("v_sub_f32_e32 %0, %1, %2":"=v"(r):"v"(a),"v"(b));return r;}
typedef float f32x2_t __attribute__((ext_vector_type(2))); typedef __bf16 bf16x2_t __attribute__((ext_vector_type(2)));
__device__ __forceinline__ unsigned cvtpk_s(float lo,float hi){f32x2_t v={lo,hi};bf16x2_t b=__builtin_convertvector(v,bf16x2_t);return __builtin_bit_cast(unsigned,b);}
#define WAIT_BAR(N) asm volatile("s_waitcnt vmcnt(" #N ") lgkmcnt(0)\n\ts_barrier":::"memory")

__device__ __forceinline__ void qkt(f32x16&p0,f32x16&p1,const char*Kslot,const bf16x8*qr,const f32x16&negm,int r32,int hi){
  const char*kb=Kslot+hi*1024+r32*16;
  #pragma unroll
  for(int d0=0;d0<4;++d0){
    const bf16x8 b0=*reinterpret_cast<const bf16x8*>(kb+d0*2048);
    const bf16x8 b1=*reinterpret_cast<const bf16x8*>(kb+d0*2048+512);
    if(d0==0){p0=__builtin_amdgcn_mfma_f32_32x32x16_bf16(b0,qr[0],negm,0,0,0);p1=__builtin_amdgcn_mfma_f32_32x32x16_bf16(b1,qr[0],negm,0,0,0);}
    else{p0=__builtin_amdgcn_mfma_f32_32x32x16_bf16(b0,qr[d0],p0,0,0,0);p1=__builtin_amdgcn_mfma_f32_32x32x16_bf16(b1,qr[d0],p1,0,0,0);}}
}
typedef __attribute__((address_space(3))) const char* lds_cptr;
typedef short v4i16_t __attribute__((ext_vector_type(4)));
__device__ __forceinline__ void kload8(bf16x8*kf,lds_cptr kp){
  kf[0]=*(const __attribute__((address_space(3))) bf16x8*)(kp);      kf[1]=*(const __attribute__((address_space(3))) bf16x8*)(kp+512);
  kf[2]=*(const __attribute__((address_space(3))) bf16x8*)(kp+2048); kf[3]=*(const __attribute__((address_space(3))) bf16x8*)(kp+2560);
  kf[4]=*(const __attribute__((address_space(3))) bf16x8*)(kp+4096); kf[5]=*(const __attribute__((address_space(3))) bf16x8*)(kp+4608);
  kf[6]=*(const __attribute__((address_space(3))) bf16x8*)(kp+6144); kf[7]=*(const __attribute__((address_space(3))) bf16x8*)(kp+6656);
}
__device__ __forceinline__ void kload2(bf16x8*kf,lds_cptr kp,int j){ kf[2*j]=*(const __attribute__((address_space(3))) bf16x8*)(kp+j*2048); kf[2*j+1]=*(const __attribute__((address_space(3))) bf16x8*)(kp+j*2048+512); }
__device__ __forceinline__ s16x4 vtr(lds_cptr p){ return __builtin_bit_cast(s16x4,__builtin_amdgcn_ds_read_tr16_b64_v4i16((__attribute__((address_space(3))) v4i16_t*)p)); }
__device__ __forceinline__ float rowmax(const f32x16&p0,const f32x16&p1){
  float a=max3f(p0[0],p0[1],p1[0]),b=max3f(p0[2],p0[3],p1[1]);a=max3f(a,p1[2],p1[3]);
  #pragma unroll
  for(int r=4;r<16;r+=4){a=max3f(a,p0[r],p0[r+1]);b=max3f(b,p0[r+2],p0[r+3]);a=max3f(a,p1[r],p1[r+1]);b=max3f(b,p1[r+2],p1[r+3]);}
  const float m=max2f(a,b);
  auto rr=__builtin_amdgcn_permlane32_swap(__float_as_uint(m),__float_as_uint(m),false,false);
  return max2f(__uint_as_float(rr[0]),__uint_as_float(rr[1]));
}
__device__ __forceinline__ void pv(f32x16*o,int vb,bf16x8 pa0,bf16x8 pa1,bf16x8 pa2,bf16x8 pa3){
  #pragma unroll
  for(int d0=0;d0<2;++d0){s16x4 lo[4],hi[4];
    #pragma unroll
    for(int ks=0;ks<4;++ks){
      asm volatile("ds_read_b64_tr_b16 %0,%1 offset:%c2":"=&v"(lo[ks]):"v"(vb),"i"(d0*4096+ks*1024):"memory");
      asm volatile("ds_read_b64_tr_b16 %0,%1 offset:%c2":"=&v"(hi[ks]):"v"(vb),"i"(d0*4096+ks*1024+512):"memory");}
    asm volatile("s_waitcnt lgkmcnt(0)":::"memory");SBAR();
    #define PK(k) (bf16x8){lo[k][0],lo[k][1],lo[k][2],lo[k][3],hi[k][0],hi[k][1],hi[k][2],hi[k][3]}
    o[d0]=__builtin_amdgcn_mfma_f32_32x32x16_bf16(pa0,PK(0),o[d0],0,0,0);
    o[d0]=__builtin_amdgcn_mfma_f32_32x32x16_bf16(pa1,PK(1),o[d0],0,0,0);
    o[d0]=__builtin_amdgcn_mfma_f32_32x32x16_bf16(pa2,PK(2),o[d0],0,0,0);
    o[d0]=__builtin_amdgcn_mfma_f32_32x32x16_bf16(pa3,PK(3),o[d0],0,0,0);
    #undef PK
  }
}

#ifndef ATTN_STORE16
#define ATTN_STORE16(p,v) (*(u32x4*)(p)=(v))
#endif
template<int THRL> __device__ __forceinline__ void attn_unit(int b,int h,int qb,const bf16*Q,const bf16*__restrict__ K,const bf16*__restrict__ V,bf16*O,const float*km,char*shm){
  int tid_l=threadIdx.x; asm volatile("":"+v"(tid_l)); const int tid=tid_l,lane=tid&63,r32=lane&31,hi=lane>>5; const int wid=__builtin_amdgcn_readfirstlane(tid>>6);
  const long rowbase=(long)b*SEQ; const int q0=qb*QB;
  const bf16*Qw=Q+(rowbase+q0+wid*QBLK)*DM+h*D;
  const bf16*Kh=K+rowbase*DM+h*D,*Vh=V+rowbase*DM+h*D;
  const unsigned lds0=(unsigned)(uintptr_t)shm;
  float*wsf=(float*)(shm+LDS_WS)+wid*64;
  const bf16*ksrc=Kh+(long)lane*DM+wid*8;
  const bf16*vsrc=Vh+(long)(16*(wid&3)+(lane>>2))*DM+(wid>>2)*32+(lane&3)*8;
  const unsigned kdst=lds0+LDS_K+wid*1024, vdst=lds0+LDS_V+wid*1024;
  #define DMA_K(t,slot) glds16(ksrc+(long)(t)*KVBLK*DM,(unsigned)__builtin_amdgcn_readfirstlane(kdst+(slot)))
  #define DMA_V(t,slot) glds16(vsrc+(long)(t)*KVBLK*DM,(unsigned)__builtin_amdgcn_readfirstlane(vdst+(slot)))
  const int vb0=(int)(lds0+LDS_V)+((lane>>4)&1)*32+(lane&3)*8+(4*hi+((lane&15)>>2))*64;
  const char*Kbase=shm+LDS_K; bf16x8 kf[8];
  const lds_cptr shm3=(lds_cptr)shm; const lds_cptr kp0=shm3+LDS_K+hi*1024+r32*16; const lds_cptr vp0=shm3+LDS_V+((lane>>4)&1)*32+(lane&3)*8+(4*hi+((lane&15)>>2))*64;
  const int NT=(q0+QB)/KVBLK;
  DMA_K(0,0);DMA_V(0,0);DMA_K(1,SLOTB);
  bf16x8 qr[4];
  #pragma unroll
  for(int d0=0;d0<4;++d0)qr[d0]=*reinterpret_cast<const bf16x8*>(&Qw[(long)r32*DM+d0*16+hi*8]);

  unsigned sel=(1u<<qb)-1u;
  if(qb>3){
    float rt[7];
    #pragma unroll
    for(int j=0;j<7;++j){ float pr=-INFINITY;
      if(j<qb){ const float*kp=km+j*64+8*hi; float s=0.f;
        #pragma unroll
        for(int d0=0;d0<4;++d0){ const f32x4v ka=*(const f32x4v*)(kp+16*d0)+*(const f32x4v*)(kp+32768+16*d0), kb2=*(const f32x4v*)(kp+16*d0+4)+*(const f32x4v*)(kp+32768+16*d0+4);
          s+=bf2f(qr[d0][0])*ka[0]+bf2f(qr[d0][1])*ka[1]+bf2f(qr[d0][2])*ka[2]+bf2f(qr[d0][3])*ka[3]+bf2f(qr[d0][4])*kb2[0]+bf2f(qr[d0][5])*kb2[1]+bf2f(qr[d0][6])*kb2[2]+bf2f(qr[d0][7])*kb2[3]; }
        s+=__shfl_xor(s,32); pr=s; }
      rt[j]=pr; }
    sel=0u;
    #pragma unroll
    for(int j=0;j<7;++j){ int rank=0;
      #pragma unroll
      for(int i=0;i<7;++i){ if(i!=j) rank+=((rt[i]>rt[j])||((rt[i]==rt[j])&&(i<j)))?1:0; }
      if(j<qb&&rank<3) sel|=(1u<<j); }
  }
  const float NEGB=-16384.f;
  float mhat=0.f,l_reg=0.f;f32x16 o[2];o[0]=f32x16{};o[1]=f32x16{};f32x16 negm=f32x16{};asm volatile("":"+v"(negm));
  const int qrel=wid*QBLK+r32;
  #define CMASK(P0,P1,t) do{int jb_=(t)-(NT-4); if(jb_>=0)cmask(P0,P1,jb_,qrel,hi); else if(!((sel>>((t)>>2))&1u)){ _Pragma("unroll") for(int r_=0;r_<16;++r_){P0[r_]=NEGB;P1[r_]=NEGB;} } }while(0)
  bool resc=false;
  #define START(P0,P1) do{ const float rm=rowmax(P0,P1); resc=false; \
    { const float dl=rm; mhat=fadd_s(mhat,dl); \
      _Pragma("unroll") for(int r=0;r<16;++r){P0[r]=fsub_s(P0[r],dl);P1[r]=fsub_s(P1[r],dl);} \
      _Pragma("unroll") for(int r=0;r<16;++r)negm[r]=-mhat; asm volatile("":"+v"(negm)); } \
    _Pragma("unroll") for(int r=0;r<16;++r)P0[r]=__builtin_amdgcn_exp2f(P0[r]); }while(0)
  #define RESC() do{ if(resc){ asm volatile("s_waitcnt lgkmcnt(0)":::"memory"); \
      _Pragma("unroll") for(int d_=0;d_<2;++d_) _Pragma("unroll") for(int r=0;r<16;++r)o[d_][r]*=wsf[crow(r,hi)]; } }while(0)
  f32x16 pA0,pA1,pB0,pB1;
  int sl_prev=0,sl_cur=0,sl_next=SLOTB;
  #define ROT() do{sl_prev=sl_cur;sl_cur=sl_next;sl_next=(sl_next==(NSLOT-1)*SLOTB)?0:sl_next+SLOTB;}while(0)
  DMA_K(2,2*SLOTB);
  WAIT_BAR(3);
  qkt(pA0,pA1,Kbase,qr,negm,r32,hi);asm volatile("s_nop 15\n\ts_nop 7":"+v"(pA0),"+v"(pA1));CMASK(pA0,pA1,0);
  START(pA0,pA1);
  _Pragma("unroll") for(int r=0;r<16;++r)pA1[r]=__builtin_amdgcn_exp2f(pA1[r]);
  WAIT_BAR(0);
  DMA_K(3,0);DMA_V(1,SLOTB);
  ROT();
  kload8(kf,kp0+sl_cur);
  WAIT_BAR(2);
  s16x4 vlo[8],vhi[8]; u32x4 pw0,pw1,pw2,pw3;
  #define PKW(P,B) cvtpk_s(P[B],P[B+1])
  #define PAF(k) __builtin_bit_cast(bf16x8,pw##k)
  #define VFR(i) (bf16x8){vlo[i][0],vlo[i][1],vlo[i][2],vlo[i][3],vhi[i][0],vhi[i][1],vhi[i][2],vhi[i][3]}
  #define PIN(x) asm volatile("":"+v"(x))
  #define MX3(a,b,c) __builtin_fmaxf(__builtin_fmaxf((a),(b)),(c))
  #define GAPA(MF,A0,A1,A2,A3,W0,W1,PW) do{ MF; sacc+=A0; sacc+=A1; sacc+=A2; sacc+=A3; PIN(sacc); W0; W1; PIN(PW); SBAR(); }while(0)
  #define EX(v) __builtin_amdgcn_exp2f(v)
  #define GAPB(MF,X,B) do{ MF; X[B]=EX(X[B]); X[B+1]=EX(X[B+1]); X[B+2]=EX(X[B+2]); X[B+3]=EX(X[B+3]); PIN(X); SBAR(); }while(0)
  #define VRD(i) do{ vlo[i]=vtr(vp_+(((i)>>2)*4096+((i)&3)*1024)); vhi[i]=vtr(vp_+(((i)>>2)*4096+((i)&3)*1024+512)); }while(0)
  #define KRD(G,j) do{ if(G){ kload2(kf,kp0+sl_next,j); SBAR(); } }while(0)
  #define STEP(C0,C1,P0,P1,t,GK,GV,GL) do{ SBAR(); \
    const lds_cptr vp_=vp0+sl_prev; \
    VRD(0); SBAR(); float sacc=(P0[0]+P0[1]); \
    GAPA(C0=__builtin_amdgcn_mfma_f32_32x32x16_bf16(kf[0],qr[0],negm,0,0,0), P0[2],P0[3],P0[4],P0[5],     pw0[0]=PKW(P0,0), pw0[1]=PKW(P0,2), pw0); \
    VRD(4); SBAR(); GAPA(C1=__builtin_amdgcn_mfma_f32_32x32x16_bf16(kf[1],qr[0],negm,0,0,0), P0[6],P0[7],P0[8],P0[9],     pw0[2]=PKW(P0,4), pw0[3]=PKW(P0,6), pw0); \
    VRD(1); SBAR(); GAPA(C0=__builtin_amdgcn_mfma_f32_32x32x16_bf16(kf[2],qr[1],C0,0,0,0),   P0[10],P0[11],P0[12],P0[13], pw1[0]=PKW(P0,8), pw1[1]=PKW(P0,10), pw1); \
    VRD(5); SBAR(); GAPA(C1=__builtin_amdgcn_mfma_f32_32x32x16_bf16(kf[3],qr[1],C1,0,0,0),   P0[14],P0[15],P1[0],P1[1],   pw1[2]=PKW(P0,12),pw1[3]=PKW(P0,14), pw1); \
    VRD(2); SBAR(); GAPA(C0=__builtin_amdgcn_mfma_f32_32x32x16_bf16(kf[4],qr[2],C0,0,0,0),   P1[2],P1[3],P1[4],P1[5],     pw2[0]=PKW(P1,0), pw2[1]=PKW(P1,2), pw2); \
    VRD(6); SBAR(); GAPA(C1=__builtin_amdgcn_mfma_f32_32x32x16_bf16(kf[5],qr[2],C1,0,0,0),   P1[6],P1[7],P1[8],P1[9],     pw2[2]=PKW(P1,4), pw2[3]=PKW(P1,6), pw2); \
    VRD(3); SBAR(); GAPA(C0=__builtin_amdgcn_mfma_f32_32x32x16_bf16(kf[6],qr[3],C0,0,0,0),   P1[10],P1[11],P1[12],P1[13], pw3[0]=PKW(P1,8), pw3[1]=PKW(P1,10), pw3); \
    VRD(7); SBAR(); GAPA(C1=__builtin_amdgcn_mfma_f32_32x32x16_bf16(kf[7],qr[3],C1,0,0,0),   P1[14],P1[15],0.f,0.f,       pw3[2]=PKW(P1,12),pw3[3]=PKW(P1,14), pw3); \
    l_reg+=sacc; \
    if(GK){DMA_K((t)+3,sl_cur);} if(GV){DMA_V((t)+1,sl_next);} \
    CMASK(C0,C1,t); \
    { float a=MX3(C0[0],C0[1],C1[0]),b=MX3(C0[2],C0[3],C1[1]); a=MX3(a,C1[2],C1[3]); \
      _Pragma("unroll") for(int r=4;r<16;r+=4){a=MX3(a,C0[r],C0[r+1]);b=MX3(b,C0[r+2],C0[r+3]);a=MX3(a,C1[r],C1[r+1]);b=MX3(b,C1[r+2],C1[r+3]);} \
      float rm=__builtin_fmaxf(a,b); { auto rr=__builtin_amdgcn_permlane32_swap(__float_as_uint(rm),__float_as_uint(rm),false,false); rm=__builtin_fmaxf(__uint_as_float(rr[0]),__uint_as_float(rr[1])); } \
      resc=false; \
      if(__builtin_expect(__any(rm>(float)THRL),0)){ const float dl=__builtin_fmaxf(rm,0.f); mhat+=dl; \
        _Pragma("unroll") for(int r=0;r<16;++r){C0[r]-=dl;C1[r]-=dl;} \
        _Pragma("unroll") for(int r=0;r<16;++r)negm[r]=-mhat; asm volatile("":"+v"(negm)); \
        const float f=__builtin_amdgcn_exp2f(-dl); l_reg*=f; if(hi==0)wsf[r32]=f; resc=true; } } \
    SBAR(); \
    GAPB(o[0]=__builtin_amdgcn_mfma_f32_32x32x16_bf16(PAF(0),VFR(0),o[0],0,0,0), C0,0); \
    GAPB(o[1]=__builtin_amdgcn_mfma_f32_32x32x16_bf16(PAF(0),VFR(4),o[1],0,0,0), C0,4); \
    KRD(GL,0); GAPB(o[0]=__builtin_amdgcn_mfma_f32_32x32x16_bf16(PAF(1),VFR(1),o[0],0,0,0), C0,8); \
    KRD(GL,1); GAPB(o[1]=__builtin_amdgcn_mfma_f32_32x32x16_bf16(PAF(1),VFR(5),o[1],0,0,0), C0,12); \
    KRD(GL,2); GAPB(o[0]=__builtin_amdgcn_mfma_f32_32x32x16_bf16(PAF(2),VFR(2),o[0],0,0,0), C1,0); \
    KRD(GL,3); GAPB(o[1]=__builtin_amdgcn_mfma_f32_32x32x16_bf16(PAF(2),VFR(6),o[1],0,0,0), C1,4); \
    GAPB(o[0]=__builtin_amdgcn_mfma_f32_32x32x16_bf16(PAF(3),VFR(3),o[0],0,0,0), C1,8); \
    GAPB(o[1]=__builtin_amdgcn_mfma_f32_32x32x16_bf16(PAF(3),VFR(7),o[1],0,0,0), C1,12); \
    }while(0)
  int t=1;
  for(;t+5<NT;t+=2){
    STEP(pB0,pB1,pA0,pA1,t,true,true,true);     WAIT_BAR(2); RESC(); ROT();
    STEP(pA0,pA1,pB0,pB1,t+1,true,true,true);   WAIT_BAR(2); RESC(); ROT();
  }
  #define ENDW(tt) do{ if((tt)+3<NT){WAIT_BAR(2);} else if((tt)+2<NT){WAIT_BAR(1);} else {WAIT_BAR(0);} }while(0)
  for(;t+1<NT;t+=2){
    STEP(pB0,pB1,pA0,pA1,t,(t+3<NT),(t+1<NT),(t+1<NT));       ENDW(t);   RESC(); ROT();
    STEP(pA0,pA1,pB0,pB1,t+1,(t+4<NT),(t+2<NT),(t+2<NT));     ENDW(t+1); RESC(); ROT();
  }
  STEP(pB0,pB1,pA0,pA1,NT-1,false,false,false); RESC();
  { float sacc=pB0[0]+pB0[1]; _Pragma("unroll") for(int r=2;r<16;++r)sacc+=pB0[r]; _Pragma("unroll") for(int r=0;r<16;++r)sacc+=pB1[r]; l_reg+=sacc;
    pw0=(u32x4){PKW(pB0,0),PKW(pB0,2),PKW(pB0,4),PKW(pB0,6)};pw1=(u32x4){PKW(pB0,8),PKW(pB0,10),PKW(pB0,12),PKW(pB0,14)};pw2=(u32x4){PKW(pB1,0),PKW(pB1,2),PKW(pB1,4),PKW(pB1,6)};pw3=(u32x4){PKW(pB1,8),PKW(pB1,10),PKW(pB1,12),PKW(pB1,14)};
    SBAR(); pv(o,vb0+sl_cur,PAF(0),PAF(1),PAF(2),PAF(3)); }
  #undef PKW
  #undef PAF
  #undef VFR
  #undef PIN
  #undef MX3
  #undef GAPA
  #undef GAPB
  #undef EX
  #undef VRD
  #undef KRD
  #undef STEP
  #undef ENDW
  {auto rr=__builtin_amdgcn_permlane32_swap(__float_as_uint(l_reg),__float_as_uint(l_reg),false,false);l_reg=__uint_as_float(rr[0])+__uint_as_float(rr[1]);}
  if(hi==0)wsf[32+r32]=l_reg;asm volatile("s_waitcnt lgkmcnt(0)":::"memory");
  float rli[16];
  #pragma unroll
  for(int r=0;r<16;++r)rli[r]=__builtin_amdgcn_rcpf(wsf[32+crow(r,hi)]);
  bf16*Ow=O+(rowbase+q0+wid*QBLK)*OPITCH+h*D;
  { bf16*stg=(bf16*)(shm+LDS_OST)+wid*2048;
    #pragma unroll
    for(int r=0;r<16;++r){const int orow=crow(r,hi);
      #pragma unroll
      for(int d0=0;d0<2;++d0)stg[orow*64+d0*32+r32]=__float2bfloat16(o[d0][r]*rli[r]);}
    asm volatile("s_waitcnt lgkmcnt(0)":::"memory");
    #pragma unroll
    for(int i=0;i<4;++i){const int row=i*8+(lane>>3),ch=lane&7; const u32x4 v=*(const u32x4*)(stg+row*64+ch*8); ATTN_STORE16(Ow+(long)row*OPITCH+ch*8,v);} }
  asm volatile("s_waitcnt lgkmcnt(0)\n\ts_barrier":::"memory");
  #undef DMA_K
  #undef DMA_V
  #undef CMASK
  #undef START
  #undef RESC
  #undef ROT
}
constexpr int ATTN_LDS_BYTES=LDS_BYTES;
#undef SBAR
#undef WAIT_BAR
}

#define GAS __attribute__((address_space(1)))
#define LAS __attribute__((address_space(3)))
typedef unsigned short bf16;
typedef unsigned v4u __attribute__((ext_vector_type(4)));
typedef unsigned v2u __attribute__((ext_vector_type(2)));
typedef float f32x4 __attribute__((ext_vector_type(4)));
typedef short bf16x8 __attribute__((ext_vector_type(8)));
#define LDS_WAIT() asm volatile("s_waitcnt lgkmcnt(0)" ::: "memory")
__device__ __forceinline__ unsigned f2bf(float f) { unsigned u = __builtin_bit_cast(unsigned, f); return (u + 0x7fffu + ((u >> 16) & 1u)) >> 16; }
__device__ __forceinline__ unsigned pk2(float lo, float hi) { return f2bf(lo) | (f2bf(hi) << 16); }

#ifndef PROBE
#define PROBE 0
#endif
constexpr int NWAVES = 8;
constexpr int DMODEL = 1024, NBATCH = 8, SEQL = 2048, MROWS = NBATCH * SEQL, NLAYER = 4;
constexpr int INW = 4608, DFF = 2816, UPW = 2 * DFF, NMODW = 6 * DMODEL;
constexpr int COL_Q = 0, COL_K = 512, COL_V = 1024, COL_U = 1536, COL_VS = 2048, COL_GA = 2560, COL_GS = 3584;
constexpr float RMS_EPS = 1e-6f;

constexpr size_t MiB = 1u << 20;
constexpr size_t WS_MOD = 0, WS_BAR = 896 * 1024, WS_BAR_BYTES = 16384, WS_KMS = 1 * MiB;
constexpr size_t WS_WIN = 2 * MiB;
constexpr size_t WS_WA = 11 * MiB;
constexpr size_t WS_WS = 12 * MiB;
constexpr size_t WS_WO = 13 * MiB;
constexpr size_t WS_WUP = 15 * MiB;
constexpr size_t WS_WDN = 26 * MiB;
constexpr size_t WS_WSG = 31 * MiB + 512 * 1024;
constexpr size_t WS_R1 = 32 * MiB;
constexpr size_t WS_G = 208 * MiB;
constexpr size_t WS_H = WS_G, WS_MG = WS_G + 32 * MiB;
constexpr size_t WS_SGO = WS_G + 64 * MiB;
constexpr size_t WS_ATT = 296 * MiB;
constexpr size_t WS_END = 312 * MiB;

constexpr int RING_BYTES = 131072;
constexpr int LDS_BYTES = 147456;
constexpr int LDS_MISC = RING_BYTES;

__device__ __forceinline__ float wave_sum(float v) {
#pragma unroll
    for (int o = 1; o < 64; o <<= 1) v += __shfl_xor(v, o);
    return v;
}

__device__ __forceinline__ void transpose_item(const float* W, int K, int N, bf16* WT, LAS float* scr, int item, int lane) {
    const int nblk = N / 32, kb = item / nblk, nb = item % nblk, k0 = 64 * kb, n0 = 32 * nb;
#pragma unroll 8
    for (int i = 0; i < 32; ++i) { const int kk = 2 * i + (lane >> 5); scr[kk * 33 + (lane & 31)] = W[(size_t)(k0 + kk) * N + n0 + (lane & 31)]; }
    LDS_WAIT(); asm volatile("" ::: "memory");
    const int c = lane & 7;
#pragma unroll
    for (int j = 0; j < 4; ++j) { const int n = (lane >> 3) + 8 * j; const LAS float* s = scr + (8 * c) * 33 + n;
        v4u o; o.x = pk2(s[0 * 33], s[1 * 33]); o.y = pk2(s[2 * 33], s[3 * 33]); o.z = pk2(s[4 * 33], s[5 * 33]); o.w = pk2(s[6 * 33], s[7 * 33]);
        *(v4u*)(WT + (size_t)(n0 + n) * K + k0 + 8 * c) = o; }
    LDS_WAIT(); asm volatile("" ::: "memory");
}

__device__ __forceinline__ void norm_mod_row(const float* xrow, const float* g, const float* sc, const float* sh, bf16* orow, int lane) {
    f32x4 v[4]; float s = 0.f;
#pragma unroll
    for (int j = 0; j < 4; ++j) { v[j] = *(const f32x4*)(xrow + 4 * lane + 256 * j); s += (v[j].x * v[j].x + v[j].y * v[j].y) + (v[j].z * v[j].z + v[j].w * v[j].w); }
    const float rstd = 1.0f / sqrtf(wave_sum(s) * (1.0f / DMODEL) + RMS_EPS);
#pragma unroll
    for (int j = 0; j < 4; ++j) { const int c = 4 * lane + 256 * j;
        const f32x4 g4 = *(const f32x4*)(g + c), s4 = *(const f32x4*)(sc + c), h4 = *(const f32x4*)(sh + c);
        const f32x4 y = (v[j] * rstd * g4) * (s4 + 1.0f) + h4;
        v2u o; o.x = pk2(y.x, y.y); o.y = pk2(y.z, y.w); *(v2u*)(orow + c) = o; }
}
__device__ __forceinline__ void norm_final_row(const float* xrow, const float* g, float* orow, int lane) {
    f32x4 v[4]; float s = 0.f;
#pragma unroll
    for (int j = 0; j < 4; ++j) { v[j] = *(const f32x4*)(xrow + 4 * lane + 256 * j); s += (v[j].x * v[j].x + v[j].y * v[j].y) + (v[j].z * v[j].z + v[j].w * v[j].w); }
    const float rstd = 1.0f / sqrtf(wave_sum(s) * (1.0f / DMODEL) + RMS_EPS);
#pragma unroll
    for (int j = 0; j < 4; ++j) { const int c = 4 * lane + 256 * j; const f32x4 g4 = *(const f32x4*)(g + c); *(f32x4*)(orow + c) = v[j] * rstd * g4; }
}

__device__ __forceinline__ void phase_mod(const float* c, const float* w_mod, float* modp, LAS float* cact, int tid, int lane, int gw, int NGW) {
    for (int i = tid; i < NBATCH * DMODEL; i += NWAVES * 64) { const float v = c[i]; cact[i] = v / (1.0f + __expf(-v)); }
    __syncthreads();
    for (int it = gw; it < 96 * 16; it += NGW) {
        const int cgp = it % 96, kc = it / 96, l = cgp / 24, n0 = (cgp % 24) * 256 + 4 * lane;
        const float* wp = w_mod + ((size_t)l * DMODEL + kc * 64) * NMODW + n0;
        f32x4 acc[8];
#pragma unroll
        for (int b = 0; b < 8; ++b) acc[b] = (f32x4){0.f, 0.f, 0.f, 0.f};
#pragma unroll 8
        for (int k = 0; k < 64; ++k) { const f32x4 w = *(const f32x4*)(wp + (size_t)k * NMODW);
#pragma unroll
            for (int b = 0; b < 8; ++b) acc[b] += w * cact[b * DMODEL + kc * 64 + k]; }
#pragma unroll
        for (int b = 0; b < 8; ++b) *(f32x4*)(modp + ((size_t)(kc * 32 + l * 8 + b)) * NMODW + n0) = acc[b];
    }
}

__device__ __forceinline__ void phase_mod_reduce(const float* modp, const float* b_mod, float* mod, int gtid, int NGT) {
    for (int i4 = gtid; i4 < NLAYER * 8 * NMODW / 4; i4 += NGT) { const int i = i4 * 4, lb = i / NMODW, n = i % NMODW, l = lb >> 3;
        f32x4 s = *(const f32x4*)(b_mod + (size_t)l * NMODW + n);
#pragma unroll
        for (int kc = 0; kc < 16; ++kc) s += *(const f32x4*)(modp + ((size_t)(kc * 32 + lb)) * NMODW + n);
        *(f32x4*)(mod + i) = s; }
}

__device__ __forceinline__ void sgu_unit(int unit, const bf16* P, bf16* SO, const float* g_sgu, const bf16* Wsm, const float* b_s, LAS unsigned char* lds, int tid, int lane, int wave) {
    const int ihalf = unit & 1, bc = unit >> 1;
    const size_t row0 = (size_t)bc * 128;
    const int jmax = ihalf ? 128 : 64;
    LAS float* rstd = (LAS float*)(lds + LDS_MISC);
    for (int tt = 0; tt < 16; ++tt) { const int tok = wave * 16 + tt;
        const v4u w = *(const v4u*)(P + (row0 + tok) * INW + COL_VS + 8 * lane);
        float s = 0.f;
#pragma unroll
        for (int i = 0; i < 4; ++i) { const float a = pg8::bf_lo(w[i]), b2 = pg8::bf_hi(w[i]); s += a * a + b2 * b2; }
        s = wave_sum(s);
        if (lane == 0) rstd[tok] = 1.0f / sqrtf(s * (1.0f / 512.0f) + RMS_EPS);
    }
    __syncthreads();
    const int g = wave;
    LAS unsigned char* vt = lds + g * 16384;
    { const int c0 = (lane & 7) * 8; float gs[8];
#pragma unroll
        for (int e = 0; e < 8; ++e) gs[e] = g_sgu[g * 64 + c0 + e];
        for (int it = 0; it < jmax / 8; ++it) { const int j = it * 8 + (lane >> 3);
            const v4u w = *(const v4u*)(P + (row0 + j) * INW + COL_VS + g * 64 + c0);
            const float r = rstd[j];
#pragma unroll
            for (int e = 0; e < 8; ++e) { const float x = (e & 1) ? pg8::bf_hi(w[e >> 1]) : pg8::bf_lo(w[e >> 1]); const int c = c0 + e;
                *(LAS unsigned short*)(vt + c * 256 + ((((j >> 3) ^ (c & 15)) << 4) | ((j & 7) * 2))) = (unsigned short)f2bf(x * r * gs[e]); }
        }
    }
    LDS_WAIT(); asm volatile("" ::: "memory");
    f32x4 acc[4][4];
#pragma unroll
    for (int a = 0; a < 4; ++a)
#pragma unroll
        for (int b = 0; b < 4; ++b) acc[a][b] = (f32x4){0.f, 0.f, 0.f, 0.f};
    const int l15 = lane & 15, kq = lane >> 4;
    const bf16* Wg = Wsm + (size_t)g * 128 * 128;
    for (int ks = 0; ks < jmax / 32; ++ks) {
        bf16x8 af[4];
#pragma unroll
        for (int ct = 0; ct < 4; ++ct) { const int c = ct * 16 + l15; af[ct] = *(const LAS bf16x8*)(vt + c * 256 + (((ks * 4 + kq) ^ (c & 15)) << 4)); }
#pragma unroll
        for (int it = 0; it < 4; ++it) { const int itg = ihalf * 4 + it;
            if (32 * ks <= 16 * itg + 15) {
                const bf16x8 bfr = *(const bf16x8*)(Wg + (size_t)(itg * 16 + l15) * 128 + ks * 32 + 8 * kq);
#pragma unroll
                for (int ct = 0; ct < 4; ++ct) acc[it][ct] = __builtin_amdgcn_mfma_f32_16x16x32_bf16(af[ct], bfr, acc[it][ct], 0, 0, 0);
            } }
    }
#pragma unroll
    for (int it = 0; it < 4; ++it) { const int i = (ihalf * 4 + it) * 16 + l15; const float bias = b_s[g * 128 + i];
#pragma unroll
        for (int ct = 0; ct < 4; ++ct) { const bf16* up = P + (row0 + i) * INW + COL_U + g * 64 + ct * 16 + 4 * kq;
            const v2u uw = *(const v2u*)up; const f32x4 d = acc[it][ct];
            v2u o; o.x = pk2(pg8::bf_lo(uw.x) * (d[0] + bias), pg8::bf_hi(uw.x) * (d[1] + bias)); o.y = pk2(pg8::bf_lo(uw.y) * (d[2] + bias), pg8::bf_hi(uw.y) * (d[3] + bias));
            *(v2u*)(SO + (row0 + i) * 512 + g * 64 + ct * 16 + 4 * kq) = o; } }
    __syncthreads();
}

__device__ __forceinline__ void phase_conv(const bf16* U, const float* w_conv, const float* b_conv, bf16* Gb, int gtid, int NGT) {
    for (int idx = gtid; idx < (MROWS / 16) * (DFF / 8); idx += NGT) {
        const int rc = idx / (DFF / 8), cc = idx % (DFF / 8), c0 = cc * 8, t0 = rc * 16;
        float w0[16], w1[16], w2[16], bb[16], p1[16], p2[16];
#pragma unroll
        for (int hsel = 0; hsel < 2; ++hsel)
#pragma unroll
            for (int q = 0; q < 2; ++q) { const int col = hsel * DFF + c0 + 4 * q;
                const f32x4 a = *(const f32x4*)(w_conv + col), b = *(const f32x4*)(w_conv + UPW + col), c = *(const f32x4*)(w_conv + 2 * UPW + col), d = *(const f32x4*)(b_conv + col);
#pragma unroll
                for (int i = 0; i < 4; ++i) { w0[hsel * 8 + q * 4 + i] = a[i]; w1[hsel * 8 + q * 4 + i] = b[i]; w2[hsel * 8 + q * 4 + i] = c[i]; bb[hsel * 8 + q * 4 + i] = d[i]; } }
        const bool first = (t0 & (SEQL - 1)) == 0;
#pragma unroll
        for (int hsel = 0; hsel < 2; ++hsel) {
            v4u a = (v4u){0u, 0u, 0u, 0u}, b = (v4u){0u, 0u, 0u, 0u};
            if (!first) { a = *(const v4u*)(U + (size_t)(t0 - 2) * UPW + hsel * DFF + c0); b = *(const v4u*)(U + (size_t)(t0 - 1) * UPW + hsel * DFF + c0); }
#pragma unroll
            for (int i = 0; i < 4; ++i) { p2[hsel * 8 + 2 * i] = pg8::bf_lo(a[i]); p2[hsel * 8 + 2 * i + 1] = pg8::bf_hi(a[i]); p1[hsel * 8 + 2 * i] = pg8::bf_lo(b[i]); p1[hsel * 8 + 2 * i + 1] = pg8::bf_hi(b[i]); }
        }
#pragma unroll 2
        for (int t = 0; t < 16; ++t) {
            const v4u ua = *(const v4u*)(U + (size_t)(t0 + t) * UPW + c0), ul = *(const v4u*)(U + (size_t)(t0 + t) * UPW + DFF + c0);
            float cur[16], o[8];
#pragma unroll
            for (int i = 0; i < 4; ++i) { cur[2 * i] = pg8::bf_lo(ua[i]); cur[2 * i + 1] = pg8::bf_hi(ua[i]); cur[8 + 2 * i] = pg8::bf_lo(ul[i]); cur[8 + 2 * i + 1] = pg8::bf_hi(ul[i]); }
#pragma unroll
            for (int i = 0; i < 8; ++i) {
                const float a = bb[i] + w2[i] * cur[i] + w1[i] * p1[i] + w0[i] * p2[i];
                const float li = bb[8 + i] + w2[8 + i] * cur[8 + i] + w1[8 + i] * p1[8 + i] + w0[8 + i] * p2[8 + i];
                o[i] = a * pg8::fast_sigmoid(a) * li; }
#pragma unroll
            for (int i = 0; i < 16; ++i) { p2[i] = p1[i]; p1[i] = cur[i]; }
            v4u w; w.x = pk2(o[0], o[1]); w.y = pk2(o[2], o[3]); w.z = pk2(o[4], o[5]); w.w = pk2(o[6], o[7]);
            *(v4u*)(Gb + (size_t)(t0 + t) * DFF + c0) = w;
        }
    }
}

#define RLX_AGENT __ATOMIC_RELAXED, __HIP_MEMORY_SCOPE_AGENT
#define XB_TMO      128
#define XB_XCNT(j)  (256  + 64 * (j))
#define XB_XSUB(j)  (1280 + 64 * (j))
#define XB_XGEN(j)  (2304 + 64 * (j))
#define XB_TOP      3328
#define XB_TOPGEN   3392
#define XCD_BAR_WORDS 3456
#define XB_SPIN_CAP (1u << 18)

__device__ __forceinline__ unsigned xb_ld(unsigned* p)              { return __hip_atomic_load(p, __ATOMIC_RELAXED, __HIP_MEMORY_SCOPE_AGENT); }
__device__ __forceinline__ unsigned xb_add(unsigned* p, unsigned v) { return __hip_atomic_fetch_add(p, v, __ATOMIC_RELAXED, __HIP_MEMORY_SCOPE_AGENT); }
__device__ __forceinline__ unsigned xb_xcc_id() { return (unsigned)__builtin_amdgcn_s_getreg((3 << 11) | 20) & 0xFu; }
#define XB_SPIN(cond, bar) do { unsigned _sp = 0; while (cond) { __builtin_amdgcn_s_sleep(1); \
    if ((++_sp & 255u) == 0u) { if (xb_ld(&(bar)[XB_TMO])) break; if (_sp > XB_SPIN_CAP) { atomicAdd(&(bar)[XB_TMO], 1u); break; } } } } while (0)

struct XcdBarrier {
    unsigned* bar; unsigned x;
    volatile LAS unsigned* st;
};

__device__ __forceinline__ XcdBarrier xcd_barrier_post(unsigned* bar, volatile LAS unsigned* st) {
    XcdBarrier b; b.bar = bar; b.x = xb_xcc_id(); b.st = st;
    if (threadIdx.x == 0) (void)xb_add(&bar[XB_XCNT(b.x)], 1u);
    return b;
}
__device__ __forceinline__ void xcd_barrier_complete(unsigned* bar, unsigned x, unsigned& nloc, unsigned& nx) {
    const unsigned G = gridDim.x * gridDim.y * gridDim.z;
    unsigned sum, cnt, mine, sp = 0u;
    for (;;) {
        sum = 0u; cnt = 0u; mine = 0u;
#pragma unroll
        for (unsigned j = 0; j < 16; ++j) { const unsigned c = xb_ld(&bar[XB_XCNT(j)]); sum += c; cnt += (c > 0u) ? 1u : 0u; mine = (j == x) ? c : mine; }
        if (sum == G) break;
        __builtin_amdgcn_s_sleep(1);
        if ((++sp & 255u) == 0u) { if (xb_ld(&bar[XB_TMO])) break; if (sp > XB_SPIN_CAP) { atomicAdd(&bar[XB_TMO], 1u); break; } }
    }
    nloc = mine > 0u ? mine : 1u; nx = cnt > 0u ? cnt : 1u;
}

__device__ __forceinline__ void xcd_barrier(const XcdBarrier& b) {
    asm volatile("s_waitcnt vmcnt(0)" ::: "memory");
    __syncthreads();
    if (threadIdx.x == 0) {
        unsigned* bar = b.bar;
        __builtin_amdgcn_s_waitcnt(0);
        unsigned nloc = b.st[0], nx = b.st[1];
        if (nloc == 0u) { xcd_barrier_complete(bar, b.x, nloc, nx); b.st[0] = nloc; b.st[1] = nx; }
        const unsigned old = xb_add(&bar[XB_XSUB(b.x)], 1u);
        const unsigned gen = old / nloc;
        if (old + 1u == (gen + 1u) * nloc) {
            __builtin_amdgcn_fence(__ATOMIC_RELEASE, "agent");
            asm volatile("s_waitcnt vmcnt(0)" ::: "memory");
            const unsigned og = xb_add(&bar[XB_TOP], 1u);
            const unsigned tg = og / nx;
            if (og + 1u == (tg + 1u) * nx) xb_add(&bar[XB_TOPGEN], 1u);
            else XB_SPIN(xb_ld(&bar[XB_TOPGEN]) == tg, bar);
            __builtin_amdgcn_fence(__ATOMIC_ACQUIRE, "agent");
            xb_add(&bar[XB_XGEN(b.x)], 1u);
            asm volatile("s_waitcnt vmcnt(0)" ::: "memory");
        } else {
            XB_SPIN(xb_ld(&bar[XB_XGEN(b.x)]) == gen, bar);
            __builtin_amdgcn_fence(__ATOMIC_ACQUIRE, "agent");
            asm volatile("s_waitcnt vmcnt(0)" ::: "memory");
        }
    }
    __syncthreads();
}

struct Args { const float* in[18]; float* out; unsigned char* ws; };
typedef __attribute__((address_space(4))) const char* kptr_t;
#define KA_INIT kptr_t ka_ = (kptr_t)__builtin_amdgcn_kernarg_segment_ptr(); asm volatile("" : "+s"(ka_));
#define ARG_IN(i) (*(const float* const __attribute__((address_space(4)))*)(ka_ + 8 * (i)))
#define ARG_OUT (*(float* const __attribute__((address_space(4)))*)(ka_ + 8 * 18))
#define ARG_WS (*(unsigned char* const __attribute__((address_space(4)))*)(ka_ + 8 * 19))
#define PHASE_IDS KA_INIT int tid = threadIdx.x; asm volatile("" : "+v"(tid)); const int lane = tid & 63, wave = __builtin_amdgcn_readfirstlane(tid >> 6), G = gridDim.x, NGW = G * NWAVES, gw = blockIdx.x * NWAVES + wave; \
    unsigned char* const ws = ARG_WS; (void)lane; (void)gw; (void)NGW; (void)ws;
#define GRID_SYNC() do { KA_INIT XcdBarrier xb_; xb_.bar = (unsigned*)(ARG_WS + WS_BAR); xb_.x = xb_xcc_id(); xb_.st = (volatile LAS unsigned*)((LAS unsigned char*)lds_raw + LDS_MISC + 1024); xcd_barrier(xb_); } while (0)

__global__ void __launch_bounds__(NWAVES * 64, 2) fwd_mega(Args args) {
    extern __shared__ __attribute__((aligned(16))) unsigned char lds_raw[];
    LAS unsigned char* lds = (LAS unsigned char*)lds_raw;
    if (args.ws == nullptr) { cg::grid_group grid = cg::this_grid(); grid.sync(); }
    {
        volatile LAS unsigned* xst = (volatile LAS unsigned*)(lds + LDS_MISC + 1024);
        if (threadIdx.x == 0) { xst[0] = 0u; xst[1] = 0u; }
        __syncthreads();
        (void)xcd_barrier_post((unsigned*)(args.ws + WS_BAR), xst);
    }
    for (int rep_ = 0; rep_ < ((PROBE == 11) ? 5 : 1); ++rep_) { if (rep_) GRID_SYNC(); PHASE_IDS phase_mod(ARG_IN(1), ARG_IN(2), (float*)(ws + WS_R1), (LAS float*)lds, tid, lane, gw, NGW); }
    GRID_SYNC();
    { PHASE_IDS phase_mod_reduce((const float*)(ws + WS_R1), ARG_IN(3), (float*)(ws + WS_MOD), blockIdx.x * (NWAVES * 64) + tid, G * NWAVES * 64); }
    GRID_SYNC();

#pragma unroll 1
    for (int l = 0; l < NLAYER; ++l) {
        for (int rep_ = 0; rep_ < ((PROBE == 4) ? 2 : 1); ++rep_) {
            if (rep_) GRID_SYNC();
            PHASE_IDS
            LAS float* scr = (LAS float*)(lds + wave * 16384);
            const float* w_in = ARG_IN(5) + (size_t)l * DMODEL * INW; const float* w_a = ARG_IN(9) + (size_t)l * 512 * DMODEL; const float* w_s = ARG_IN(10) + (size_t)l * 512 * DMODEL;
            const float* w_o = ARG_IN(11) + (size_t)l * DMODEL * DMODEL; const float* w_up = ARG_IN(13) + (size_t)l * DMODEL * UPW; const float* w_dn = ARG_IN(16) + (size_t)l * DFF * DMODEL;
            constexpr int I_IN = (DMODEL / 64) * (INW / 32), I_A = (512 / 64) * (DMODEL / 32), I_O = (DMODEL / 64) * (DMODEL / 32), I_UP = (DMODEL / 64) * (UPW / 32), I_DN = (DFF / 64) * (DMODEL / 32);
            constexpr int NITEMS = I_IN + 2 * I_A + I_O + I_UP + I_DN;
            for (int it = gw; it < NITEMS; it += NGW) {
                int r = it;
                if (r < I_IN) { transpose_item(w_in, DMODEL, INW, (bf16*)(ws + WS_WIN), scr, r, lane); continue; } r -= I_IN;
                if (r < I_A) { transpose_item(w_a, 512, DMODEL, (bf16*)(ws + WS_WA), scr, r, lane); continue; } r -= I_A;
                if (r < I_A) { transpose_item(w_s, 512, DMODEL, (bf16*)(ws + WS_WS), scr, r, lane); continue; } r -= I_A;
                if (r < I_O) { transpose_item(w_o, DMODEL, DMODEL, (bf16*)(ws + WS_WO), scr, r, lane); continue; } r -= I_O;
                if (r < I_UP) { transpose_item(w_up, DMODEL, UPW, (bf16*)(ws + WS_WUP), scr, r, lane); continue; } r -= I_UP;
                transpose_item(w_dn, DFF, DMODEL, (bf16*)(ws + WS_WDN), scr, r, lane);
            }
            const float* wsg = ARG_IN(7) + (size_t)l * 8 * 128 * 128; bf16* Wsm = (bf16*)(ws + WS_WSG);
            for (int ch = blockIdx.x * (NWAVES * 64) + tid; ch < 8 * 128 * 16; ch += G * NWAVES * 64) {
                const int i = (ch >> 4) & 127, j0 = (ch & 15) * 8;
                const f32x4 a = *(const f32x4*)(wsg + (size_t)ch * 8), b = *(const f32x4*)(wsg + (size_t)ch * 8 + 4);
                float v[8] = {a[0], a[1], a[2], a[3], b[0], b[1], b[2], b[3]};
#pragma unroll
                for (int e = 0; e < 8; ++e) if (j0 + e > i) v[e] = 0.f;
                v4u o; o.x = pk2(v[0], v[1]); o.y = pk2(v[2], v[3]); o.z = pk2(v[4], v[5]); o.w = pk2(v[6], v[7]);
                *(v4u*)(Wsm + (size_t)ch * 8) = o;
            }
            const float* gmix = ARG_IN(4) + (size_t)l * DMODEL; const float* modl = (const float*)(ws + WS_MOD) + (size_t)l * 8 * NMODW;
            const float* Xin = (l == 0) ? ARG_IN(0) : ARG_OUT; bf16* H = (bf16*)(ws + WS_H);
            for (int m = gw; m < MROWS; m += NGW) { const float* mb = modl + (size_t)(m >> 11) * NMODW;
                norm_mod_row(Xin + (size_t)m * DMODEL, gmix, mb + DMODEL, mb, H + (size_t)m * DMODEL, lane); }
        }
        GRID_SYNC();
        for (int rep_ = 0; rep_ < ((PROBE == 1) ? 2 : 1); ++rep_) {
            if (rep_) GRID_SYNC();
            KA_INIT unsigned char* const ws = ARG_WS;
            pg8::Gemm g{(bf16*)(ws + WS_H), (bf16*)(ws + WS_WIN), MROWS, INW, DMODEL, DMODEL}; pg8::StaticOrder S; S.init(MROWS, INW, (int)gridDim.x, (int)blockIdx.x);
            pg8::EpiIn E{(bf16*)(ws + WS_R1), (float*)(ws + WS_KMS) + (size_t)l * 65536};
            pg8::gemm_phase<pg8::EpiIn, pg8::StaticOrder, true, true>(lds, g, S, E);
        }
        GRID_SYNC();
        {
            { KA_INIT unsigned char* const ws = ARG_WS; bf16* P = (bf16*)(ws + WS_R1); const float* kms = (const float*)(ws + WS_KMS) + (size_t)l * 65536;
              for (int rep_ = 0; rep_ < ((PROBE == 7) ? 2 : 1); ++rep_)
              for (int i = blockIdx.x; i < 256; i += gridDim.x) {
                const int bh = i >> 2, s = i & 3;
#pragma unroll 1
                for (int k = 0; k < 2; ++k) { const int qb = k ? s : 7 - s;
                    attn_body::attn_unit<8>(bh >> 3, bh & 7, qb, (const attn_body::bf16*)(P + COL_Q), (const attn_body::bf16*)(P + COL_K), (const attn_body::bf16*)(P + COL_V), (attn_body::bf16*)(ws + WS_ATT),
                                            kms + (size_t)bh * 512, (char*)lds_raw); }
              } }
            __syncthreads();
            { PHASE_IDS
              const float* gsgu = ARG_IN(6) + (size_t)l * 512; const float* bs = ARG_IN(8) + (size_t)l * 8 * 128;
              for (int rep_ = 0; rep_ < ((PROBE == 8) ? 2 : 1); ++rep_)
              for (int i = blockIdx.x; i < 256; i += G) sgu_unit(i, (const bf16*)(ws + WS_R1), (bf16*)(ws + WS_SGO), gsgu, (const bf16*)(ws + WS_WSG), bs, lds, tid, lane, wave); }
        }
        GRID_SYNC();
        for (int rep_ = 0; rep_ < ((PROBE == 2) ? 2 : 1); ++rep_) {
            if (rep_) GRID_SYNC();
            KA_INIT unsigned char* const ws = ARG_WS;
            pg8::Gemm g{(bf16*)(ws + WS_ATT), (bf16*)(ws + WS_WA), MROWS, DMODEL, 512, 512, (bf16*)(ws + WS_SGO), (bf16*)(ws + WS_WS)}; pg8::DualOrder S; S.init(MROWS, DMODEL, (int)gridDim.x, (int)blockIdx.x);
            pg8::EpiBranch2 E{(bf16*)(ws + WS_R1), (bf16*)(ws + WS_MG)};
            pg8::gemm_phase<pg8::EpiBranch2, pg8::DualOrder, true, true>(lds, g, S, E);
        }
        GRID_SYNC();
        for (int rep_ = 0; rep_ < ((PROBE == 9) ? 2 : 1); ++rep_) {
            if (rep_) GRID_SYNC();
            KA_INIT unsigned char* const ws = ARG_WS; const float* modl = (const float*)(ws + WS_MOD) + (size_t)l * 8 * NMODW;
            pg8::Gemm g{(bf16*)(ws + WS_MG), (bf16*)(ws + WS_WO), MROWS, DMODEL, DMODEL, DMODEL}; pg8::StaticOrder S; S.init(MROWS, DMODEL, (int)gridDim.x, (int)blockIdx.x);
            pg8::EpiRes E{(l == 0) ? ARG_IN(0) : (const float*)ARG_OUT, (PROBE == 9 && rep_ == 0) ? (float*)(ws + 312 * MiB) : ARG_OUT, modl + 2 * DMODEL};
            pg8::gemm_phase<pg8::EpiRes, pg8::StaticOrder, true, true>(lds, g, S, E);
        }
        GRID_SYNC();
        if (PROBE == 5) { for (int rep_ = 0; rep_ < 10; ++rep_) GRID_SYNC(); }
        for (int rep_ = 0; rep_ < ((PROBE == 6) ? 2 : 1); ++rep_) {
            if (rep_) GRID_SYNC();
            PHASE_IDS
            const float* gffn = ARG_IN(12) + (size_t)l * DMODEL; const float* modl = (const float*)(ws + WS_MOD) + (size_t)l * 8 * NMODW; const float* X = ARG_OUT; bf16* H = (bf16*)(ws + WS_H);
            for (int m = gw; m < MROWS; m += NGW) { const float* mb = modl + (size_t)(m >> 11) * NMODW;
                norm_mod_row(X + (size_t)m * DMODEL, gffn, mb + 4 * DMODEL, mb + 3 * DMODEL, H + (size_t)m * DMODEL, lane); }
        }
        GRID_SYNC();
        for (int rep_ = 0; rep_ < ((PROBE == 1) ? 2 : 1); ++rep_) {
            if (rep_) GRID_SYNC();
            KA_INIT unsigned char* const ws = ARG_WS;
            pg8::Gemm g{(bf16*)(ws + WS_H), (bf16*)(ws + WS_WUP), MROWS, UPW, DMODEL, DMODEL}; pg8::StaticOrder S; S.init(MROWS, UPW, (int)gridDim.x, (int)blockIdx.x);
            pg8::EpiPlain E{(bf16*)(ws + WS_R1), UPW};
            pg8::gemm_phase<pg8::EpiPlain, pg8::StaticOrder, true, true>(lds, g, S, E);
        }
        GRID_SYNC();
        for (int rep_ = 0; rep_ < ((PROBE == 3) ? 2 : 1); ++rep_) { if (rep_) GRID_SYNC(); PHASE_IDS
            phase_conv((const bf16*)(ws + WS_R1), ARG_IN(14) + (size_t)l * 3 * UPW, ARG_IN(15) + (size_t)l * UPW, (bf16*)(ws + WS_G), blockIdx.x * (NWAVES * 64) + tid, G * NWAVES * 64); }
        GRID_SYNC();
        for (int rep_ = 0; rep_ < ((PROBE == 10) ? 2 : 1); ++rep_) {
            if (rep_) GRID_SYNC();
            KA_INIT unsigned char* const ws = ARG_WS; const float* modl = (const float*)(ws + WS_MOD) + (size_t)l * 8 * NMODW;
            pg8::Gemm g{(bf16*)(ws + WS_G), (bf16*)(ws + WS_WDN), MROWS, DMODEL, DFF, DFF}; pg8::StaticOrder S; S.init(MROWS, DMODEL, (int)gridDim.x, (int)blockIdx.x);
            pg8::EpiRes E{ARG_OUT, (PROBE == 10 && rep_ == 0) ? (float*)(ws + 312 * MiB) : ARG_OUT, modl + 5 * DMODEL};
            pg8::gemm_phase<pg8::EpiRes, pg8::StaticOrder, true, true>(lds, g, S, E);
        }
        GRID_SYNC();
    }
    { PHASE_IDS float* X = ARG_OUT; const float* gf = ARG_IN(17); for (int m = gw; m < MROWS; m += NGW) norm_final_row(X + (size_t)m * DMODEL, gf, X + (size_t)m * DMODEL, lane); }
}

extern "C" void kernel_launch(void* const* d_in, const int* in_sizes, int n_in, void* d_out, int out_size, void* d_ws, size_t ws_size, hipStream_t stream) {
    static int grid = 0;
    if (grid == 0) {
        if (n_in != 18 || in_sizes[0] != MROWS * DMODEL || out_size != MROWS * DMODEL || ws_size < WS_END) {
            fprintf(stderr, "kernel_launch: unexpected shapes (n_in %d, in0 %d, out %d, ws %zu); nothing launched\n", n_in, n_in > 0 ? in_sizes[0] : -1, out_size, ws_size); grid = -1; return; }
        int dev = 0, cus = 0, per_cu = 0;
        hipGetDevice(&dev); hipDeviceGetAttribute(&cus, hipDeviceAttributeMultiprocessorCount, dev);
        if (hipFuncSetAttribute((const void*)fwd_mega, hipFuncAttributeMaxDynamicSharedMemorySize, LDS_BYTES) != hipSuccess) { fprintf(stderr, "kernel_launch: hipFuncSetAttribute failed\n"); grid = -1; return; }
        if (hipOccupancyMaxActiveBlocksPerMultiprocessor(&per_cu, (const void*)fwd_mega, NWAVES * 64, LDS_BYTES) != hipSuccess || per_cu < 1) { fprintf(stderr, "kernel_launch: occupancy query gave %d\n", per_cu); per_cu = 1; }
        (void)hipGetLastError();
        grid = cus * per_cu;
        fprintf(stderr, "kernel_launch: grid %d (%d CUs x %d)\n", grid, cus, per_cu);
    }
    if (grid < 0) return;
    hipMemsetAsync((char*)d_ws + WS_BAR, 0, WS_BAR_BYTES, stream);
    Args a{};
    for (int i = 0; i < 18; ++i) a.in[i] = (const float*)d_in[i];
    a.out = (float*)d_out; a.ws = (unsigned char*)d_ws;
    void* kargs[] = {&a};
    hipError_t e = hipLaunchCooperativeKernel((const void*)fwd_mega, dim3(grid), dim3(NWAVES * 64), kargs, LDS_BYTES, stream);
    if (e != hipSuccess) fprintf(stderr, "kernel_launch: cooperative launch failed: %s (grid %d)\n", hipGetErrorString(e), grid);
}
```
